# Optimizing an MI355X kernel written in HIP

```python
import jax, jax.numpy as jnp
from jax import lax
import numpy as np

D_MODEL = 1024
BATCH = 8
SEQ = 4096
DEPTH = 2

HEAD_DIM = 64
POOL_WIDTH = D_MODEL // 4
POOL_WINDOWS = (2, 4, 8, 16)
POOL_GROUPS = len(POOL_WINDOWS)
POOL_GROUP_WIDTH = POOL_WIDTH // POOL_GROUPS
RET_WIDTH = 3 * D_MODEL // 8
RET_HEADS = RET_WIDTH // HEAD_DIM
RET_CHUNK = 128
NSA_WIDTH = D_MODEL - POOL_WIDTH - RET_WIDTH
NSA_HEADS = NSA_WIDTH // HEAD_DIM
NSA_KV_HEADS = 2
NSA_KV_WIDTH = NSA_KV_HEADS * HEAD_DIM
CMP_BLOCK = 32
CMP_STRIDE = 16
CMP_HIDDEN = 128
SLC_BLOCK = 64
SLC_TOP = 16
SLC_QCHUNK = 64
WINDOW = 512
WIN_QBLOCK = 128
N_BRANCH = 3
FORCE_SCORE = 1e6
MIX_WIDTH = POOL_WIDTH + RET_WIDTH + NSA_WIDTH
D_FF = 2816
CONV_WIDTH = 3
ROPE_THETA = 10000.0
LN_EPS = 1e-5
GN_EPS = 1e-5
DEEPNORM_ALPHA = (2 * DEPTH) ** 0.25
DEEPNORM_BETA = (8 * DEPTH) ** -0.25
IN_SPLITS = (POOL_WIDTH, RET_WIDTH, RET_WIDTH, RET_WIDTH, RET_WIDTH, NSA_WIDTH,
             NSA_KV_WIDTH, NSA_KV_WIDTH, NSA_KV_WIDTH, NSA_KV_WIDTH, NSA_KV_WIDTH, NSA_KV_WIDTH,
             NSA_HEADS * N_BRANCH)
IN_IS_VALUE = (True, False, False, True, False, False, False, True, False, True, False, True, False)
IN_WIDTH = sum(IN_SPLITS)

kernel_name = 'hybrid_pool_retention_nsa_deepnorm'


def _layernorm(x, g, b):
    xf = x.astype(jnp.float32)
    mu = jnp.mean(xf, axis=-1, keepdims=True)
    var = jnp.mean(jnp.square(xf - mu), axis=-1, keepdims=True)
    return ((xf - mu) * lax.rsqrt(var + LN_EPS) * g + b).astype(x.dtype)


def _rope(x, pos):
    dh = x.shape[-1]
    inv = ROPE_THETA ** (-jnp.arange(0, dh, 2, dtype=jnp.float32) / dh)
    ang = pos.astype(jnp.float32)[..., None] * inv
    cos = jnp.cos(ang)[:, :, None, :]
    sin = jnp.sin(ang)[:, :, None, :]
    xf = x.astype(jnp.float32)
    x1, x2 = xf[..., : dh // 2], xf[..., dh // 2:]
    return jnp.concatenate([x1 * cos - x2 * sin, x2 * cos + x1 * sin], axis=-1).astype(x.dtype)


def _masked_softmax(s, mask):
    s = jnp.where(mask, s, -1e30)
    p = jax.nn.softmax(s, axis=-1)
    return jnp.where(mask, p, 0.0)


def _pool_mixer(v, pool_w, pool_scale):
    b, t, _ = v.shape
    vg = v.reshape(b, t, POOL_GROUPS, POOL_GROUP_WIDTH).astype(jnp.float32)
    cs = jnp.pad(jnp.cumsum(vg, axis=1), ((0, 0), (1, 0), (0, 0), (0, 0)))
    tpos = jnp.arange(t)
    pooled = []
    for gi, w in enumerate(POOL_WINDOWS):
        lo = jnp.maximum(tpos + 1 - w, 0)
        cnt = (tpos + 1 - lo).astype(jnp.float32)[None, :, None]
        pooled.append((cs[:, 1:, gi] - cs[:, lo, gi]) / cnt)
    mixed = (jnp.stack(pooled, axis=2) - vg).astype(v.dtype)
    y = jnp.einsum('btgc,gcd->btgd', mixed, pool_w).reshape(b, t, POOL_WIDTH)
    return y * pool_scale


def _retention(q, k, v, g, gn_g, pos):
    b, t, _ = q.shape
    h, dh, c = RET_HEADS, HEAD_DIM, RET_CHUNK
    n = t // c
    f32 = jnp.float32
    qr = _rope(q.reshape(b, t, h, dh), pos).astype(f32)
    kr = _rope(k.reshape(b, t, h, dh), pos).astype(f32) * (dh ** -0.5)
    qc = qr.reshape(b, n, c, h, dh)
    kc = kr.reshape(b, n, c, h, dh)
    vc = v.reshape(b, n, c, h, dh).astype(f32)
    log_gamma = jnp.log1p(-jnp.power(2.0, -5.0 - jnp.arange(h, dtype=f32)))
    i = jnp.arange(c, dtype=f32)
    diff = i[:, None] - i[None, :]
    dmask = jnp.where(diff >= 0, jnp.exp(log_gamma[:, None, None] * jnp.maximum(diff, 0.0)), 0.0)
    xi = jnp.exp(log_gamma[:, None] * (i + 1.0))
    zeta = jnp.exp(log_gamma[:, None] * (c - 1.0 - i))
    gamma_c = jnp.exp(log_gamma * c)
    s = jnp.einsum('bnihd,bnjhd->bnhij', qc, kc) * dmask
    inner = jnp.einsum('bnhij,bnjhd->bnihd', s, vc)
    kv = jnp.einsum('bnjhd,bnjhe,hj->bnhde', kc, vc, zeta)

    def step(state, kv_i):
        return gamma_c[None, :, None, None] * state + kv_i, state

    _, r_prev = lax.scan(step, jnp.zeros((b, h, dh, dh), f32), jnp.moveaxis(kv, 1, 0))
    cross = jnp.einsum('bnihd,nbhde,hi->bnihe', qc, r_prev, xi)
    o = (inner + cross).reshape(b, t, h, dh)
    mu = jnp.mean(o, axis=-1, keepdims=True)
    var = jnp.mean(jnp.square(o - mu), axis=-1, keepdims=True)
    on = ((o - mu) * lax.rsqrt(var + GN_EPS)).reshape(b, t, RET_WIDTH) * gn_g
    return (jax.nn.silu(g.astype(f32)) * on).astype(q.dtype)


def _compress(kv, pos_emb, w1, b1, w2):
    b, t, _ = kv.shape
    n_cmp = (t - CMP_BLOCK) // CMP_STRIDE + 1
    blk_idx = (jnp.arange(n_cmp) * CMP_STRIDE)[:, None] + jnp.arange(CMP_BLOCK)[None, :]
    blocks = kv.reshape(b, t, NSA_KV_HEADS, HEAD_DIM)[:, blk_idx] + pos_emb[None, None, :, None, :]
    flat = jnp.moveaxis(blocks, 3, 2).reshape(b, n_cmp, NSA_KV_HEADS, CMP_BLOCK * HEAD_DIM)
    return jax.nn.gelu(flat @ w1 + b1) @ w2


def _nsa(q, k_cmp, v_cmp, k_slc, v_slc, k_win, v_win, gate, pos,
         cmp_pos_k, cmp_w1_k, cmp_b1_k, cmp_w2_k, cmp_pos_v, cmp_w1_v, cmp_b1_v, cmp_w2_v):
    b, t, _ = q.shape
    hq, gk, dh = NSA_HEADS, NSA_KV_HEADS, HEAD_DIM
    rep = hq // gk
    f32 = jnp.float32
    tq = jnp.arange(t)
    qg = (_rope(q.reshape(b, t, hq, dh), pos).astype(f32) * (dh ** -0.5)).reshape(b, t, gk, rep, dh)

    n_cmp = (t - CMP_BLOCK) // CMP_STRIDE + 1
    ends = jnp.arange(n_cmp) * CMP_STRIDE + CMP_BLOCK - 1
    kc = _rope(_compress(k_cmp, cmp_pos_k, cmp_w1_k, cmp_b1_k, cmp_w2_k), pos[:, ends]).astype(f32)
    vc = _compress(v_cmp, cmp_pos_v, cmp_w1_v, cmp_b1_v, cmp_w2_v).astype(f32)
    s_c = jnp.einsum('btgrd,bngd->bgrtn', qg, kc)
    p_c = _masked_softmax(s_c, ends[None, :] <= tq[:, None])
    o_cmp = jnp.einsum('bgrtn,bngd->btgrd', p_c, vc)

    n_slc = t // SLC_BLOCK
    ci = jnp.arange(n_cmp)[:, None]
    sj = jnp.arange(n_slc)[None, :]
    overlap = jnp.clip(jnp.minimum(ci * CMP_STRIDE + CMP_BLOCK, (sj + 1) * SLC_BLOCK)
                       - jnp.maximum(ci * CMP_STRIDE, sj * SLC_BLOCK), 0, None).astype(f32) / CMP_STRIDE
    imp = jnp.sum(p_c, axis=2) @ overlap
    blk = jnp.arange(n_slc)[None, :]
    cur = (tq // SLC_BLOCK)[:, None]
    forced = (blk == 0) | (blk == cur) | (blk == cur - 1)
    valid = blk * SLC_BLOCK <= tq[:, None]
    score = jnp.where(valid, jnp.where(forced, FORCE_SCORE, imp), -1.0)
    _, sel = lax.top_k(score, min(SLC_TOP, n_slc))

    ks = _rope(k_slc.reshape(b, t, gk, dh), pos)
    ksb = jnp.moveaxis(ks.reshape(b, n_slc, SLC_BLOCK, gk, dh), 3, 1)
    vsb = jnp.moveaxis(v_slc.reshape(b, n_slc, SLC_BLOCK, gk, dh), 3, 1)
    nq = t // SLC_QCHUNK
    q_ch = jnp.moveaxis(qg.reshape(b, nq, SLC_QCHUNK, gk, rep, dh), 1, 0)
    sel_ch = jnp.moveaxis(jnp.transpose(sel, (0, 2, 1, 3)).reshape(b, nq, SLC_QCHUNK, gk, -1), 1, 0)
    t_ch = tq.reshape(nq, SLC_QCHUNK)
    bi = jnp.arange(b)[:, None, None, None]
    gi = jnp.arange(gk)[None, None, :, None]

    def slc_chunk(args):
        qx, sx, tx = args
        kx = ksb[bi, gi, sx].astype(f32)
        vx = vsb[bi, gi, sx].astype(f32)
        qc_ = qx.shape[1]
        kpos = sx[..., None] * SLC_BLOCK + jnp.arange(SLC_BLOCK)
        mask = jnp.transpose((kpos <= tx[None, :, None, None, None]).reshape(b, qc_, gk, -1), (0, 2, 1, 3))[:, :, None]
        s = jnp.einsum('bqgrd,bqgkld->bgrqkl', qx, kx).reshape(b, gk, rep, qc_, -1)
        p = _masked_softmax(s, mask)
        return jnp.einsum('bgrqm,bqgmd->bqgrd', p, vx.reshape(b, qc_, gk, -1, dh))

    o_slc = jnp.moveaxis(lax.map(slc_chunk, (q_ch, sel_ch, t_ch)), 0, 1).reshape(b, t, gk, rep, dh)

    nw = t // WIN_QBLOCK
    span = WINDOW + WIN_QBLOCK
    kw = _rope(k_win.reshape(b, t, gk, dh), pos)
    kp = jnp.pad(kw, ((0, 0), (WINDOW, 0), (0, 0), (0, 0)))
    vp = jnp.pad(v_win.reshape(b, t, gk, dh), ((0, 0), (WINDOW, 0), (0, 0), (0, 0)))
    qw_ch = jnp.moveaxis(qg.reshape(b, nw, WIN_QBLOCK, gk, rep, dh), 1, 0)

    def win_block(args):
        i, qx = args
        kx = lax.dynamic_slice_in_dim(kp, i * WIN_QBLOCK, span, axis=1).astype(f32)
        vx = lax.dynamic_slice_in_dim(vp, i * WIN_QBLOCK, span, axis=1).astype(f32)
        qpos = i * WIN_QBLOCK + jnp.arange(WIN_QBLOCK)
        kpos = i * WIN_QBLOCK - WINDOW + jnp.arange(span)
        d = qpos[:, None] - kpos[None, :]
        mask = (d >= 0) & (d < WINDOW) & (kpos[None, :] >= 0)
        s = jnp.einsum('bqgrd,bkgd->bgrqk', qx, kx)
        p = _masked_softmax(s, mask)
        return jnp.einsum('bgrqk,bkgd->bqgrd', p, vx)

    o_win = jnp.moveaxis(lax.map(win_block, (jnp.arange(nw), qw_ch)), 0, 1).reshape(b, t, gk, rep, dh)

    gts = jax.nn.sigmoid(gate.astype(f32)).reshape(b, t, gk, rep, N_BRANCH)
    o = gts[..., 0:1] * o_cmp + gts[..., 1:2] * o_slc + gts[..., 2:3] * o_win
    return o.reshape(b, t, NSA_WIDTH).astype(q.dtype)


def _conv_ffn(x, w_gate, w_up, conv_w, conv_b, w_down):
    t = x.shape[1]
    hg = x @ w_gate
    hp = jnp.pad(hg, ((0, 0), (CONV_WIDTH - 1, 0), (0, 0)))
    hc = conv_b
    for kk in range(CONV_WIDTH):
        hc = hc + hp[:, kk:kk + t] * conv_w[kk]
    return (jax.nn.gelu(hc) * (x @ w_up)) @ w_down


def setup_inputs(seed: int = 0) -> dict:
    key = jax.random.key(seed)
    ks = jax.random.split(key, 26)
    nrm = jax.random.normal
    col_scale = jnp.asarray(np.concatenate(
        [np.full((s,), DEEPNORM_BETA if isv else 1.0, np.float32) for s, isv in zip(IN_SPLITS, IN_IS_VALUE)]))
    cf = CMP_BLOCK * HEAD_DIM
    return {
        'x': nrm(ks[0], (BATCH, SEQ, D_MODEL), jnp.float32),
        'positions': (jnp.arange(SEQ, dtype=jnp.int32)[None, :]
                      + jax.random.randint(ks[1], (BATCH, 1), 0, 512, dtype=jnp.int32)),
        'w_in': nrm(ks[2], (DEPTH, D_MODEL, IN_WIDTH), jnp.float32) * (D_MODEL ** -0.5) * col_scale,
        'w_out': nrm(ks[3], (DEPTH, MIX_WIDTH, D_MODEL), jnp.float32) * (MIX_WIDTH ** -0.5) * DEEPNORM_BETA,
        'pool_w': nrm(ks[4], (DEPTH, POOL_GROUPS, POOL_GROUP_WIDTH, POOL_GROUP_WIDTH), jnp.float32) * (POOL_GROUP_WIDTH ** -0.5),
        'pool_scale': 1.0 + 0.1 * nrm(ks[5], (DEPTH, POOL_WIDTH), jnp.float32),
        'ret_gn_g': 1.0 + 0.1 * nrm(ks[6], (DEPTH, RET_WIDTH), jnp.float32),
        'cmp_pos_k': 0.1 * nrm(ks[7], (DEPTH, CMP_BLOCK, HEAD_DIM), jnp.float32),
        'cmp_w1_k': nrm(ks[8], (DEPTH, cf, CMP_HIDDEN), jnp.float32) * (cf ** -0.5),
        'cmp_b1_k': 0.01 * nrm(ks[9], (DEPTH, CMP_HIDDEN), jnp.float32),
        'cmp_w2_k': nrm(ks[10], (DEPTH, CMP_HIDDEN, HEAD_DIM), jnp.float32) * (CMP_HIDDEN ** -0.5),
        'cmp_pos_v': 0.1 * nrm(ks[11], (DEPTH, CMP_BLOCK, HEAD_DIM), jnp.float32),
        'cmp_w1_v': nrm(ks[12], (DEPTH, cf, CMP_HIDDEN), jnp.float32) * (cf ** -0.5),
        'cmp_b1_v': 0.01 * nrm(ks[13], (DEPTH, CMP_HIDDEN), jnp.float32),
        'cmp_w2_v': nrm(ks[14], (DEPTH, CMP_HIDDEN, HEAD_DIM), jnp.float32) * (CMP_HIDDEN ** -0.5),
        'ffn_w_gate': nrm(ks[15], (DEPTH, D_MODEL, D_FF), jnp.float32) * (D_MODEL ** -0.5),
        'ffn_w_up': nrm(ks[16], (DEPTH, D_MODEL, D_FF), jnp.float32) * (D_MODEL ** -0.5),
        'ffn_conv_w': nrm(ks[17], (DEPTH, CONV_WIDTH, D_FF), jnp.float32) * (CONV_WIDTH ** -0.5),
        'ffn_conv_b': 0.01 * nrm(ks[18], (DEPTH, D_FF), jnp.float32),
        'ffn_w_down': nrm(ks[19], (DEPTH, D_FF, D_MODEL), jnp.float32) * (D_FF ** -0.5) * DEEPNORM_BETA,
        'ln1_g': 1.0 + 0.05 * nrm(ks[20], (DEPTH, D_MODEL), jnp.float32),
        'ln1_b': 0.01 * nrm(ks[21], (DEPTH, D_MODEL), jnp.float32),
        'ln2_g': 1.0 + 0.05 * nrm(ks[22], (DEPTH, D_MODEL), jnp.float32),
        'ln2_b': 0.01 * nrm(ks[23], (DEPTH, D_MODEL), jnp.float32),
    }


def reference(x, positions, w_in, w_out, pool_w, pool_scale, ret_gn_g,
              cmp_pos_k, cmp_w1_k, cmp_b1_k, cmp_w2_k, cmp_pos_v, cmp_w1_v, cmp_b1_v, cmp_w2_v,
              ffn_w_gate, ffn_w_up, ffn_conv_w, ffn_conv_b, ffn_w_down,
              ln1_g, ln1_b, ln2_g, ln2_b):
    split_at = [int(s) for s in np.cumsum(IN_SPLITS)[:-1]]
    for l in range(DEPTH):
        h = x @ w_in[l]
        (v_pool, q_ret, k_ret, v_ret, g_ret, q_nsa, k_cmp, v_cmp,
         k_slc, v_slc, k_win, v_win, gate_nsa) = jnp.split(h, split_at, axis=-1)
        y_a = _pool_mixer(v_pool, pool_w[l], pool_scale[l])
        y_b = _retention(q_ret, k_ret, v_ret, g_ret, ret_gn_g[l], positions)
        y_c = _nsa(q_nsa, k_cmp, v_cmp, k_slc, v_slc, k_win, v_win, gate_nsa, positions,
                   cmp_pos_k[l], cmp_w1_k[l], cmp_b1_k[l], cmp_w2_k[l],
                   cmp_pos_v[l], cmp_w1_v[l], cmp_b1_v[l], cmp_w2_v[l])
        mix = jnp.concatenate([y_a, y_b, y_c], axis=-1) @ w_out[l]
        x = _layernorm(DEEPNORM_ALPHA * x + mix, ln1_g[l], ln1_b[l])
        f = _conv_ffn(x, ffn_w_gate[l], ffn_w_up[l], ffn_conv_w[l], ffn_conv_b[l], ffn_w_down[l])
        x = _layernorm(DEEPNORM_ALPHA * x + f, ln2_g[l], ln2_b[l])
    return x
```

```cpp
#include <hip/hip_runtime.h>
#include <hip/hip_cooperative_groups.h>
#include <stdint.h>
#include <stdio.h>
namespace cg = cooperative_groups;

typedef unsigned short bf16_t;
typedef __attribute__((ext_vector_type(8))) short bf16x8;
typedef __attribute__((ext_vector_type(4))) short bf16x4;
typedef __attribute__((ext_vector_type(16))) float f32x16;
typedef __attribute__((ext_vector_type(2))) __bf16 bfv2;
typedef __attribute__((ext_vector_type(2))) float fv2;
typedef unsigned long long u64;
#define DI __device__ __forceinline__
#define MFMA32(a, b, c) __builtin_amdgcn_mfma_f32_32x32x16_bf16((a), (b), (c), 0, 0, 0)

#ifndef COOP
#define COOP 1
#ifndef PROBE_DRY
#define PROBE_DRY 0
#endif
#ifndef PROBE_DM
#define PROBE_DM 0
#endif
#endif

constexpr int MTOK = 32768, SEQ = 4096, DM = 1024, NIN = 2962, NINP = 3072, DFF = 2816;
constexpr float LOG2E = 1.4426950408889634f;
constexpr float ALPHA = 1.4142135623730951f;
constexpr int NPHASE = 19;

constexpr size_t al256(size_t v) { return (v + 255) & ~(size_t)255; }
constexpr size_t M_ = MTOK;
constexpr size_t OFF_ctr = 0;
constexpr size_t OFF_stats1 = OFF_ctr + al256(16384);
constexpr size_t OFF_stats2 = OFF_stats1 + al256(M_*8);
constexpr size_t OFF_tab = OFF_stats2 + al256(M_*8);
constexpr size_t OFF_c1 = OFF_tab + al256(M_*32*8);
constexpr size_t OFF_winT = OFF_c1 + al256(4*64*128*4);
constexpr size_t OFF_woutT = OFF_winT + al256((size_t)2*NINP*DM*2);
constexpr size_t OFF_wguT = OFF_woutT + al256((size_t)2*DM*DM*2);
constexpr size_t OFF_wdT = OFF_wguT + al256((size_t)2*2*DFF*DM*2);
constexpr size_t OFF_w1T = OFF_wdT + al256((size_t)2*DM*DFF*2);
constexpr size_t OFF_w2T = OFF_w1T + al256((size_t)4*128*2048*2);
constexpr size_t OFF_pwT = OFF_w2T + al256((size_t)4*64*128*2);
constexpr size_t OFF_xb = OFF_pwT + al256((size_t)8*64*64*2);
constexpr size_t OFF_y = OFF_xb + al256(M_*DM*2);
constexpr size_t OFF_ocmp = OFF_y + al256(M_*DM*2);
constexpr size_t OFF_owin = OFF_ocmp + al256(M_*384*2);
constexpr size_t OFF_gates = OFF_owin + al256(M_*384*2);
constexpr size_t OFF_kvT = OFF_gates + al256(M_*18*4);
constexpr size_t OFF_RT = OFF_kvT + al256((size_t)48*32*4096*4);
constexpr size_t OFF_kc = OFF_RT + al256((size_t)48*32*4096*2);
constexpr size_t OFF_vcT = OFF_kc + al256((size_t)16*256*64*2);
constexpr size_t OFF_sel = OFF_vcT + al256((size_t)16*64*256*2);
constexpr size_t OFF_vpool = OFF_sel + al256((size_t)16*SEQ*8);
constexpr size_t OFF_qret = OFF_vpool + al256(M_*256*2);
constexpr size_t OFF_kret = OFF_qret + al256(M_*384*2);
constexpr size_t OFF_kzT = OFF_kret + al256(M_*384*2);
constexpr size_t OFF_vrT = OFF_kzT + al256(M_*384*2);
constexpr size_t OFF_gret = OFF_vrT + al256(M_*384*2);
constexpr size_t OFF_qnsa = OFF_gret + al256(M_*384*2);
constexpr size_t OFF_kcmp = OFF_qnsa + al256(M_*384*2);
constexpr size_t OFF_vcmp = OFF_kcmp + al256(M_*128*2);
constexpr size_t OFF_kslc = OFF_vcmp + al256(M_*128*2);
constexpr size_t OFF_vslT = OFF_kslc + al256(M_*128*2);
constexpr size_t OFF_kwin = OFF_vslT + al256(M_*128*2);
constexpr size_t OFF_vwT = OFF_kwin + al256(M_*128*2);
constexpr size_t WS_NEED = OFF_vwT + al256(M_*128*2);
constexpr size_t OFF_act = OFF_vpool;
struct Params {
  const float* x; const int* pos; const float* w_in; const float* w_out; const float* pool_w; const float* pool_scale;
  const float* gn_g; const float* cpos_k; const float* cw1_k; const float* cb1_k; const float* cw2_k;
  const float* cpos_v; const float* cw1_v; const float* cb1_v; const float* cw2_v;
  const float* wg; const float* wu; const float* convw; const float* convb; const float* wd;
  const float* ln1g; const float* ln1b; const float* ln2g; const float* ln2b;
  float* z;
  unsigned char* ws;
  DI int* ctr() const { return (int*)(ws + OFF_ctr); }
  DI float2* stats1() const { return (float2*)(ws + OFF_stats1); }
  DI float2* stats2() const { return (float2*)(ws + OFF_stats2); }
  DI float2* tab() const { return (float2*)(ws + OFF_tab); }
  DI float* c1() const { return (float*)(ws + OFF_c1); }
  DI bf16_t* winT() const { return (bf16_t*)(ws + OFF_winT); }
  DI bf16_t* woutT() const { return (bf16_t*)(ws + OFF_woutT); }
  DI bf16_t* wguT() const { return (bf16_t*)(ws + OFF_wguT); }
  DI bf16_t* wdT() const { return (bf16_t*)(ws + OFF_wdT); }
  DI bf16_t* w1T() const { return (bf16_t*)(ws + OFF_w1T); }
  DI bf16_t* w2T() const { return (bf16_t*)(ws + OFF_w2T); }
  DI bf16_t* pwT() const { return (bf16_t*)(ws + OFF_pwT); }
  DI bf16_t* xb() const { return (bf16_t*)(ws + OFF_xb); }
  DI bf16_t* y() const { return (bf16_t*)(ws + OFF_y); }
  DI bf16_t* ocmp() const { return (bf16_t*)(ws + OFF_ocmp); }
  DI bf16_t* owin() const { return (bf16_t*)(ws + OFF_owin); }
  DI float* gates() const { return (float*)(ws + OFF_gates); }
  DI float* kvT() const { return (float*)(ws + OFF_kvT); }
  DI bf16_t* RT() const { return (bf16_t*)(ws + OFF_RT); }
  DI bf16_t* kc() const { return (bf16_t*)(ws + OFF_kc); }
  DI bf16_t* vcT() const { return (bf16_t*)(ws + OFF_vcT); }
  DI u64* sel() const { return (u64*)(ws + OFF_sel); }
  DI bf16_t* vpool() const { return (bf16_t*)(ws + OFF_vpool); }
  DI bf16_t* qret() const { return (bf16_t*)(ws + OFF_qret); }
  DI bf16_t* kret() const { return (bf16_t*)(ws + OFF_kret); }
  DI bf16_t* kzT() const { return (bf16_t*)(ws + OFF_kzT); }
  DI bf16_t* vrT() const { return (bf16_t*)(ws + OFF_vrT); }
  DI bf16_t* gret() const { return (bf16_t*)(ws + OFF_gret); }
  DI bf16_t* qnsa() const { return (bf16_t*)(ws + OFF_qnsa); }
  DI bf16_t* kcmp() const { return (bf16_t*)(ws + OFF_kcmp); }
  DI bf16_t* vcmp() const { return (bf16_t*)(ws + OFF_vcmp); }
  DI bf16_t* kslc() const { return (bf16_t*)(ws + OFF_kslc); }
  DI bf16_t* vslT() const { return (bf16_t*)(ws + OFF_vslT); }
  DI bf16_t* kwin() const { return (bf16_t*)(ws + OFF_kwin); }
  DI bf16_t* vwT() const { return (bf16_t*)(ws + OFF_vwT); }
  DI bf16_t* act() const { return (bf16_t*)(ws + OFF_act); }
};

DI int tid_() { int t = __builtin_amdgcn_workitem_id_x(); asm volatile("" : "+v"(t)); return t; }
DI unsigned pack2(float a, float b) { fv2 v = {a, b}; bfv2 r = __builtin_convertvector(v, bfv2); return __builtin_bit_cast(unsigned, r); }
DI bf16_t f2bf(float a) { return (bf16_t)(pack2(a, 0.f) & 0xffffu); }
DI float bf2f(bf16_t v) { return __uint_as_float(((unsigned)v) << 16); }
DI int crow(int i, int lh) { return (i & 3) + 8 * (i >> 2) + 4 * lh; }
DI float gelu_tanh(float x) {
  float u = 0.7978845608028654f * (x + 0.044715f * x * x * x);
  float e = __expf(2.f * u);
  float th = 1.f - 2.f / (e + 1.f);
  return 0.5f * x * (1.f + th);
}
DI float sigmoidf_(float x) { return 1.f / (1.f + __expf(-x)); }
DI float xor32(float v) { return __shfl_xor(v, 32); }

DI int next_item(int* ctr, int* s_item) {
  __syncthreads();
  if (tid_() == 0) *s_item = atomicAdd(ctr, 1);
  __syncthreads();
  return *s_item;
}


DI void grid_bar(unsigned* bw, unsigned k) {
  asm volatile("s_waitcnt vmcnt(0)" ::: "memory");
  __syncthreads();
  if (tid_() == 0) {
    __builtin_amdgcn_fence(__ATOMIC_RELEASE, "agent");
    asm volatile("s_waitcnt vmcnt(0)" ::: "memory");
    const unsigned g = blockIdx.x & 7u, nloc = (gridDim.x - g + 7u) >> 3;
    const unsigned old = __hip_atomic_fetch_add(&bw[64 * g], 1u, __ATOMIC_RELAXED, __HIP_MEMORY_SCOPE_AGENT);
    if (old + 1u == k * nloc) {
      const unsigned ot = __hip_atomic_fetch_add(&bw[64 * 8], 1u, __ATOMIC_RELAXED, __HIP_MEMORY_SCOPE_AGENT);
      if (ot + 1u == k * 8u) __hip_atomic_fetch_add(&bw[64 * 9], 1u, __ATOMIC_RELAXED, __HIP_MEMORY_SCOPE_AGENT);
    }
    while (__hip_atomic_load(&bw[64 * 9], __ATOMIC_RELAXED, __HIP_MEMORY_SCOPE_AGENT) < k) __builtin_amdgcn_s_sleep(1);
    __builtin_amdgcn_fence(__ATOMIC_ACQUIRE, "agent");
    asm volatile("s_waitcnt vmcnt(0)" ::: "memory");
  }
  __syncthreads();
}

DI bool xcd_tile(int* ctr, int* s_item, int mtiles, int ntiles, int& mt, int& nt) {
  const int x = blockIdx.x & 7;
  const int q = next_item(ctr + x, s_item);
  const int per = mtiles >> 3;
  if (q >= per * ntiles) return false;
  const int fg = per >> 2, rem = per & 3;
  int ml;
  if (q < fg * 4 * ntiles) { const int g = q / (4 * ntiles), wq = q % (4 * ntiles); nt = wq >> 2; ml = 4 * g + (wq & 3); }
  else { const int q2 = q - fg * 4 * ntiles; nt = q2 / rem; ml = 4 * fg + q2 % rem; }
  mt = x * per + ml;
  return true;
}

constexpr int LDT = 72;
template <class AF>
DI void gemm_main(f32x16 (&acc)[2][2], AF af, const bf16_t* __restrict__ Bt, int ldb, int n0, int kiters, unsigned char* smem) {
  bf16_t* sA = (bf16_t*)smem;
  bf16_t* sB = (bf16_t*)(smem + 2 * 128 * LDT * 2);
  const int tid = tid_(), lane = tid & 63, w = tid >> 6, wm = w >> 1, wn = w & 1;
  const int r = lane & 31, lh = lane >> 5;
  const int lrow = tid >> 3, lch = tid & 7;
#pragma unroll
  for (int a = 0; a < 2; ++a)
#pragma unroll
    for (int b = 0; b < 2; ++b)
#pragma unroll
      for (int i = 0; i < 16; ++i) acc[a][b][i] = 0.f;
  uint4 ra[4], rb[4];
  const bf16_t* bptr = Bt + (size_t)(n0 + lrow) * ldb + lch * 8;
#define GLOAD(it)                                                                  \
  {                                                                                \
    _Pragma("unroll") for (int c = 0; c < 4; ++c) {                                \
      const bf16_t* pa = af(lrow + 32 * c, (it));                                  \
      ra[c] = pa ? *(const uint4*)(pa + lch * 8) : make_uint4(0, 0, 0, 0);         \
      rb[c] = *(const uint4*)(bptr + (size_t)(32 * c) * ldb + (it) * 64);          \
    }                                                                              \
  }
#define SSTORE(buf)                                                                \
  {                                                                                \
    _Pragma("unroll") for (int c = 0; c < 4; ++c) {                                \
      *(uint4*)(sA + (buf) * 128 * LDT + (lrow + 32 * c) * LDT + lch * 8) = ra[c]; \
      *(uint4*)(sB + (buf) * 128 * LDT + (lrow + 32 * c) * LDT + lch * 8) = rb[c]; \
    }                                                                              \
  }
  GLOAD(0);
  SSTORE(0);
  __syncthreads();
  for (int it = 0; it < kiters; ++it) {
    const int cur = it & 1;
    if (it + 1 < kiters) GLOAD(it + 1);
    const bf16_t* a_base = sA + cur * 128 * LDT + (wm * 64 + r) * LDT + 8 * lh;
    const bf16_t* b_base = sB + cur * 128 * LDT + (wn * 64 + r) * LDT + 8 * lh;
#pragma unroll
    for (int s = 0; s < 4; ++s) {
      bf16x8 a0 = *(const bf16x8*)(a_base + s * 16);
      bf16x8 a1 = *(const bf16x8*)(a_base + 32 * LDT + s * 16);
      bf16x8 b0 = *(const bf16x8*)(b_base + s * 16);
      bf16x8 b1 = *(const bf16x8*)(b_base + 32 * LDT + s * 16);
      acc[0][0] = MFMA32(a0, b0, acc[0][0]);
      acc[0][1] = MFMA32(a0, b1, acc[0][1]);
      acc[1][0] = MFMA32(a1, b0, acc[1][0]);
      acc[1][1] = MFMA32(a1, b1, acc[1][1]);
    }
    if (it + 1 < kiters) SSTORE(cur ^ 1);
    __syncthreads();
  }
#undef GLOAD
#undef SSTORE
}

template <class AF>
DI void gemm_big(f32x16 (&acc)[4][2], AF af, const bf16_t* __restrict__ Bt, int ldb, int n0, int kiters, unsigned char* smem, int dm = 0) {
  bf16_t* sA = (bf16_t*)smem;
  bf16_t* sB = (bf16_t*)(smem + 256 * LDT * 2);
  const int tid = tid_(), lane = tid & 63, w = tid >> 6, wm = w >> 1, wn = w & 1;
  const int r = lane & 31, lh = lane >> 5;
  const int lrow = tid >> 3, lch = tid & 7;
#pragma unroll
  for (int a = 0; a < 4; ++a)
#pragma unroll
    for (int b = 0; b < 2; ++b)
#pragma unroll
      for (int i = 0; i < 16; ++i) acc[a][b][i] = 0.f;
  uint4 ra0, ra1, ra2, ra3, ra4, ra5, ra6, ra7, rb0, rb1, rb2, rb3;
  const bf16_t* bptr = Bt + (size_t)(n0 + lrow) * ldb + lch * 8;
  const size_t bstep = (size_t)32 * ldb;
#define GLA(ra, c, it)                                                            \
  {                                                                               \
    const bf16_t* pa = af(lrow + 32 * (c), (it));                                 \
    ra = pa ? *(const uint4*)(pa + lch * 8) : make_uint4(0, 0, 0, 0);             \
  }
#define GLB(rb, c, it) { rb = *(const uint4*)(bptr + bstep * (c) + (it) * 64); }
#define GLOAD0(it)                                                                \
  {                                                                               \
    GLA(ra0, 0, it) GLA(ra1, 1, it) GLA(ra2, 2, it) GLA(ra3, 3, it)               \
    GLA(ra4, 4, it) GLA(ra5, 5, it) GLA(ra6, 6, it) GLA(ra7, 7, it)               \
    GLB(rb0, 0, it) GLB(rb1, 1, it) GLB(rb2, 2, it) GLB(rb3, 3, it)               \
  }
#define GLOAD1(it)                                                                \
  {                                                                               \
    GLA(qa0, 0, it) GLA(qa1, 1, it) GLA(qa2, 2, it) GLA(qa3, 3, it)               \
    GLA(qa4, 4, it) GLA(qa5, 5, it) GLA(qa6, 6, it) GLA(qa7, 7, it)               \
    GLB(qb0, 0, it) GLB(qb1, 1, it) GLB(qb2, 2, it) GLB(qb3, 3, it)               \
  }
#define SSA(ra, c, buf) { *(uint4*)(sA + (buf) * 256 * LDT + (lrow + 32 * (c)) * LDT + lch * 8) = ra; }
#define SSB(rb, c, buf) { *(uint4*)(sB + (buf) * 128 * LDT + (lrow + 32 * (c)) * LDT + lch * 8) = rb; }
#define SSTORE0(buf)                                                              \
  {                                                                               \
    SSA(ra0, 0, buf) SSA(ra1, 1, buf) SSA(ra2, 2, buf) SSA(ra3, 3, buf)           \
    SSA(ra4, 4, buf) SSA(ra5, 5, buf) SSA(ra6, 6, buf) SSA(ra7, 7, buf)           \
    SSB(rb0, 0, buf) SSB(rb1, 1, buf) SSB(rb2, 2, buf) SSB(rb3, 3, buf)           \
  }
#define SSTORE1(buf)                                                              \
  {                                                                               \
    SSA(qa0, 0, buf) SSA(qa1, 1, buf) SSA(qa2, 2, buf) SSA(qa3, 3, buf)           \
    SSA(qa4, 4, buf) SSA(qa5, 5, buf) SSA(qa6, 6, buf) SSA(qa7, 7, buf)           \
    SSB(qb0, 0, buf) SSB(qb1, 1, buf) SSB(qb2, 2, buf) SSB(qb3, 3, buf)           \
  }
#define COMPUTE(buf, LP0, LP1, LP2, LP3)                                                                     \
  {                                                                                                          \
    const bf16_t* a_base = sA + (buf) * 256 * LDT + (wm * 128 + r) * LDT + 8 * lh;                           \
    const bf16_t* b_base = sB + (buf) * 128 * LDT + (wn * 64 + r) * LDT + 8 * lh;                            \
    __builtin_amdgcn_s_setprio(1);                                                                           \
    _Pragma("unroll") for (int s = 0; s < 4; ++s) {                                                          \
      bf16x8 fa[4], fb[2];                                                                                   \
      _Pragma("unroll") for (int q = 0; q < 4; ++q) fa[q] = *(const bf16x8*)(a_base + q * 32 * LDT + s * 16); \
      _Pragma("unroll") for (int q = 0; q < 2; ++q) fb[q] = *(const bf16x8*)(b_base + q * 32 * LDT + s * 16); \
      if (s == 0) { LP0 } else if (s == 1) { LP1 } else if (s == 2) { LP2 } else { LP3 }                     \
      _Pragma("unroll") for (int mi = 0; mi < 4; ++mi)                                                       \
          _Pragma("unroll") for (int ni = 0; ni < 2; ++ni)                                                   \
              acc[mi][ni] = MFMA32(fa[mi], fb[ni], acc[mi][ni]);                                             \
      __builtin_amdgcn_sched_barrier(0);                                                                     \
    }                                                                                                        \
    __builtin_amdgcn_s_setprio(0);                                                                           \
  }
  GLOAD0(0);
  SSTORE0(0);
  __syncthreads();
  const int klast = kiters - 1;
#pragma unroll 1
  for (int it = 0; it < kiters; ++it) {
    const int i1 = (it + 1 < kiters) ? it + 1 : klast;
    COMPUTE(0, GLA(ra0, 0, i1) GLA(ra1, 1, i1) GLA(ra2, 2, i1), GLA(ra3, 3, i1) GLA(ra4, 4, i1) GLA(ra5, 5, i1),
            GLA(ra6, 6, i1) GLA(ra7, 7, i1) GLB(rb0, 0, i1), GLB(rb1, 1, i1) GLB(rb2, 2, i1) GLB(rb3, 3, i1));
    __syncthreads();
    SSTORE0(0);
    __syncthreads();
  }
#undef GLA
#undef GLB
#undef GLOAD0
#undef GLOAD1
#undef SSA
#undef SSB
#undef SSTORE0
#undef SSTORE1
#undef COMPUTE
}

struct ARowMajor {
  const bf16_t* A; int lda; int m0;
  DI const bf16_t* operator()(int row, int it) const { return A + (size_t)(m0 + row) * lda + it * 64; }
};

DI void store_rm(const f32x16 (&v)[2][2], bf16_t* dst, int ld, int row0, int col0, int r, int lh) {
#pragma unroll
  for (int mi = 0; mi < 2; ++mi)
#pragma unroll
    for (int ni = 0; ni < 2; ++ni)
#pragma unroll
      for (int i = 0; i < 16; ++i) dst[(size_t)(row0 + mi * 32 + crow(i, lh)) * ld + col0 + ni * 32 + r] = f2bf(v[mi][ni][i]);
}
DI void store_T(const f32x16 (&v)[2][2], bf16_t* dstT, int t0, int r, int lh) {
#pragma unroll
  for (int mi = 0; mi < 2; ++mi)
#pragma unroll
    for (int ni = 0; ni < 2; ++ni)
#pragma unroll
      for (int g = 0; g < 4; ++g) {
        uint2 u;
        u.x = pack2(v[mi][ni][4 * g], v[mi][ni][4 * g + 1]);
        u.y = pack2(v[mi][ni][4 * g + 2], v[mi][ni][4 * g + 3]);
        *(uint2*)(dstT + (size_t)(ni * 32 + r) * SEQ + t0 + mi * 32 + 8 * g + 4 * lh) = u;
      }
}
DI void rope_tile(f32x16 (&v)[2][2], const float2* tab, int row0, int r, int lh, float scale) {
#pragma unroll
  for (int mi = 0; mi < 2; ++mi)
#pragma unroll
    for (int i = 0; i < 16; ++i) {
      float2 cs = tab[(size_t)(row0 + mi * 32 + crow(i, lh)) * 32 + r];
      float x1 = v[mi][0][i], x2 = v[mi][1][i];
      v[mi][0][i] = (x1 * cs.x - x2 * cs.y) * scale;
      v[mi][1][i] = (x2 * cs.x + x1 * cs.y) * scale;
    }
}

constexpr int LDS_RM = 72;
constexpr int LDS_T = 136;
DI void stage_rm(const f32x16 (&v)[4][2], bf16_t* st, int r, int lh) {
#pragma unroll
  for (int mi = 0; mi < 4; ++mi)
#pragma unroll
    for (int ni = 0; ni < 2; ++ni)
#pragma unroll
      for (int i = 0; i < 16; ++i) st[(mi * 32 + crow(i, lh)) * LDS_RM + ni * 32 + r] = f2bf(v[mi][ni][i]);
}
DI void flush_rm(const bf16_t* st, bf16_t* dst, int ld, int lane) {
  const int rr = lane >> 3, ch = lane & 7;
#pragma unroll 4
  for (int k = 0; k < 16; ++k) {
    const int row = k * 8 + rr;
    *(uint4*)(dst + (size_t)row * ld + ch * 8) = *(const uint4*)(st + row * LDS_RM + ch * 8);
  }
}
DI void stage_T(const f32x16 (&v)[4][2], bf16_t* st, int r, int lh) {
#pragma unroll
  for (int mi = 0; mi < 4; ++mi)
#pragma unroll
    for (int ni = 0; ni < 2; ++ni)
#pragma unroll
      for (int g = 0; g < 4; ++g) {
        uint2 u;
        u.x = pack2(v[mi][ni][4 * g], v[mi][ni][4 * g + 1]);
        u.y = pack2(v[mi][ni][4 * g + 2], v[mi][ni][4 * g + 3]);
        *(uint2*)(st + (ni * 32 + r) * LDS_T + mi * 32 + 8 * g + 4 * lh) = u;
      }
}
DI void flush_T(const bf16_t* st, bf16_t* dstT, int lane) {
  const int dd = lane >> 4, ch = lane & 15;
#pragma unroll 4
  for (int k = 0; k < 16; ++k) {
    const int d = k * 4 + dd;
    *(uint4*)(dstT + (size_t)d * SEQ + ch * 8) = *(const uint4*)(st + d * LDS_T + ch * 8);
  }
}
DI void rope_tile4(f32x16 (&v)[4][2], const float2* tab, int row0, int r, int lh, float scale) {
#pragma unroll
  for (int mi = 0; mi < 4; ++mi) {
#pragma unroll
    for (int i = 0; i < 16; ++i) {
      float2 cs = tab[(size_t)(row0 + mi * 32 + crow(i, lh)) * 32 + r];
      float x1 = v[mi][0][i], x2 = v[mi][1][i];
      v[mi][0][i] = (x1 * cs.x - x2 * cs.y) * scale;
      v[mi][1][i] = (x2 * cs.x + x1 * cs.y) * scale;
    }
    __builtin_amdgcn_sched_barrier(0);
  }
}
DI float ret_l2g(int hd) { return log2f(1.f - exp2f(-(float)(5 + hd))); }

DI void conv_tile(const float* src, int N, bf16_t* dst, int ldd, int k0, int n0, int mode, float* st) {
  const int tid = tid_();
#pragma unroll
  for (int c = 0; c < 8; ++c) {
    const int idx = tid + 256 * c, kk = idx >> 5, n2 = idx & 31, n = n0 + 2 * n2;
    float2 v = make_float2(0.f, 0.f);
    if (n < N) v = *(const float2*)(src + (size_t)(k0 + kk) * N + n);
    st[kk * 65 + 2 * n2] = v.x;
    st[kk * 65 + 2 * n2 + 1] = v.y;
  }
  __syncthreads();
#pragma unroll
  for (int c = 0; c < 4; ++c) {
    const int idx = tid + 256 * c, nn = idx >> 4, k4 = idx & 15, n = n0 + nn;
    const int drow = (mode == 0) ? n : (64 * (n >> 5) + (mode == 2 ? 32 : 0) + (n & 31));
    uint2 u;
    u.x = pack2(st[(4 * k4) * 65 + nn], st[(4 * k4 + 1) * 65 + nn]);
    u.y = pack2(st[(4 * k4 + 2) * 65 + nn], st[(4 * k4 + 3) * 65 + nn]);
    *(uint2*)(dst + (size_t)drow * ldd + k0 + 4 * k4) = u;
  }
  __syncthreads();
}

DI void phase_prep(const Params& p, unsigned char* smem) {
  float* st = (float*)smem;
  const int tid = tid_();
  constexpr int PER = 3268;
  for (int idx = blockIdx.x; idx < 2 * PER; idx += gridDim.x) {
    int L = idx / PER, j = idx % PER;
    if (j < 768) { conv_tile(p.w_in + (size_t)L * DM * NIN, NIN, p.winT() + (size_t)L * NINP * DM, DM, (j / 48) * 64, (j % 48) * 64, 0, st); continue; }
    j -= 768;
    if (j < 256) { conv_tile(p.w_out + (size_t)L * DM * DM, DM, p.woutT() + (size_t)L * DM * DM, DM, (j / 16) * 64, (j % 16) * 64, 0, st); continue; }
    j -= 256;
    if (j < 704) { conv_tile(p.wg + (size_t)L * DM * DFF, DFF, p.wguT() + (size_t)L * 2 * DFF * DM, DM, (j / 44) * 64, (j % 44) * 64, 1, st); continue; }
    j -= 704;
    if (j < 704) { conv_tile(p.wu + (size_t)L * DM * DFF, DFF, p.wguT() + (size_t)L * 2 * DFF * DM, DM, (j / 44) * 64, (j % 44) * 64, 2, st); continue; }
    j -= 704;
    if (j < 704) { conv_tile(p.wd + (size_t)L * DFF * DM, DM, p.wdT() + (size_t)L * DM * DFF, DFF, (j / 16) * 64, (j % 16) * 64, 0, st); continue; }
    j -= 704;
    if (j < 64) { conv_tile(p.cw1_k + (size_t)L * 2048 * 128, 128, p.w1T() + (size_t)(L * 2 + 0) * 128 * 2048, 2048, (j / 2) * 64, (j % 2) * 64, 0, st); continue; }
    j -= 64;
    if (j < 64) { conv_tile(p.cw1_v + (size_t)L * 2048 * 128, 128, p.w1T() + (size_t)(L * 2 + 1) * 128 * 2048, 2048, (j / 2) * 64, (j % 2) * 64, 0, st); continue; }
    j -= 64;
    if (j < 2) { conv_tile(p.cw2_k + (size_t)L * 128 * 64, 64, p.w2T() + (size_t)(L * 2 + 0) * 64 * 128, 128, j * 64, 0, 0, st); continue; }
    j -= 2;
    conv_tile(p.cw2_v + (size_t)L * 128 * 64, 64, p.w2T() + (size_t)(L * 2 + 1) * 64 * 128, 128, j * 64, 0, 0, st);
  }
  for (int idx = blockIdx.x; idx < 8; idx += gridDim.x)
    conv_tile(p.pool_w + (size_t)idx * 4096, 64, p.pwT() + (size_t)idx * 4096, 64, 0, 0, 0, st);
  const size_t gtid = (size_t)blockIdx.x * 256 + tid, gstride = (size_t)gridDim.x * 256;
  for (size_t i = gtid; i < (size_t)MTOK * DM / 4; i += gstride) {
    float4 v = ((const float4*)p.x)[i];
    uint2 u; u.x = pack2(v.x, v.y); u.y = pack2(v.z, v.w);
    ((uint2*)p.xb())[i] = u;
  }
  for (size_t i = gtid; i < (size_t)MTOK * 32; i += gstride) {
    int tok = (int)(i >> 5), k = (int)(i & 31);
    float inv = exp2f(-(float)k * 0.41524101186092029f);
    float ang = (float)p.pos[tok] * inv;
    float kk = rintf(ang * 0.15915494309189535f);
    float rr = fmaf(-kk, 6.2831854820251465f, ang);
    rr = fmaf(-kk, -1.7484556000744883e-07f, rr);
    p.tab()[i] = make_float2(__cosf(rr), __sinf(rr));
  }
  for (int blk = blockIdx.x; blk < 256; blk += gridDim.x) {
    if (tid < 128) {
      const int lw = blk >> 6, kb = blk & 63, L = lw >> 1, which = lw & 1;
      const float* pe = (which ? p.cpos_v : p.cpos_k) + (size_t)L * 2048 + kb * 32;
      const float* w1 = (which ? p.cw1_v : p.cw1_k) + (size_t)L * 2048 * 128 + (size_t)kb * 32 * 128;
      float s = 0.f;
#pragma unroll 8
      for (int k = 0; k < 32; ++k) s = fmaf(pe[k], w1[(size_t)k * 128 + tid], s);
      p.c1()[(size_t)(lw * 64 + kb) * 128 + tid] = s;
    }
  }
}

DI void epi_inproj(f32x16 (&acc)[4][2], int m0, int n0, const Params& p, unsigned char* smem) {
  const int tid = tid_(), lane = tid & 63, w = tid >> 6, wm = w >> 1, wn = w & 1, r = lane & 31, lh = lane >> 5;
  const int cw = n0 + wn * 64;
  const int row0 = m0 + wm * 128;
  const int b = row0 >> 12, t0 = row0 & 4095;
  bf16_t* st = (bf16_t*)(smem + w * 18432);
  bf16_t* rm_dst = nullptr; int rm_ld = 0; bf16_t* t_dst = nullptr; int mode = 0;
  if (cw < 256) { rm_dst = p.vpool() + (size_t)row0 * 256 + cw; rm_ld = 256; }
  else if (cw < 640) { rm_dst = p.qret() + (size_t)row0 * 384 + (cw - 256); rm_ld = 384; mode = 1; }
  else if (cw < 1024) { rm_dst = p.kret() + (size_t)row0 * 384 + (cw - 640); rm_ld = 384; mode = 4; t_dst = p.kzT() + (size_t)((b * 6 + ((cw - 640) >> 6)) * 64) * SEQ + t0; }
  else if (cw < 1408) { t_dst = p.vrT() + (size_t)((b * 6 + ((cw - 1024) >> 6)) * 64) * SEQ + t0; }
  else if (cw < 1792) { rm_dst = p.gret() + (size_t)row0 * 384 + (cw - 1408); rm_ld = 384; mode = 3; }
  else if (cw < 2176) { rm_dst = p.qnsa() + (size_t)row0 * 384 + (cw - 1792); rm_ld = 384; mode = 2; }
  else if (cw < 2304) { rm_dst = p.kcmp() + (size_t)row0 * 128 + (cw - 2176); rm_ld = 128; }
  else if (cw < 2432) { rm_dst = p.vcmp() + (size_t)row0 * 128 + (cw - 2304); rm_ld = 128; }
  else if (cw < 2560) { rm_dst = p.kslc() + (size_t)row0 * 128 + (cw - 2432); rm_ld = 128; mode = 1; }
  else if (cw < 2688) { t_dst = p.vslT() + (size_t)((b * 2 + ((cw - 2560) >> 6)) * 64) * SEQ + t0; }
  else if (cw < 2816) { rm_dst = p.kwin() + (size_t)row0 * 128 + (cw - 2688); rm_ld = 128; mode = 1; }
  else if (cw < 2944) { t_dst = p.vwT() + (size_t)((b * 2 + ((cw - 2816) >> 6)) * 64) * SEQ + t0; }
  else if (cw == 2944) {
    if (r < 18) {
#pragma unroll
      for (int mi = 0; mi < 4; ++mi)
#pragma unroll
        for (int i = 0; i < 16; ++i) p.gates()[(size_t)(row0 + mi * 32 + crow(i, lh)) * 18 + r] = sigmoidf_(acc[mi][0][i]);
    }
  }
  if (mode == 1 || mode == 2 || mode == 4) rope_tile4(acc, p.tab(), row0, r, lh, mode == 1 ? 1.f : (mode == 2 ? 0.125f * LOG2E : 0.125f));
  if (mode == 3) {
#pragma unroll
    for (int mi = 0; mi < 4; ++mi)
#pragma unroll
      for (int ni = 0; ni < 2; ++ni)
#pragma unroll
        for (int i = 0; i < 16; ++i) { float g = acc[mi][ni][i]; acc[mi][ni][i] = g * sigmoidf_(g); }
  }
  if (rm_dst) stage_rm(acc, st, r, lh);
  __syncthreads();
  if (rm_dst) flush_rm(st, rm_dst, rm_ld, lane);
  __syncthreads();
  if (t_dst) {
    if (mode == 4) {
      const float l2g = ret_l2g((cw - 640) >> 6);
#pragma unroll
      for (int mi = 0; mi < 4; ++mi)
#pragma unroll
        for (int i = 0; i < 16; ++i) {
          int tl = (t0 + mi * 32 + crow(i, lh)) & 127;
          float zt = exp2f((float)(127 - tl) * l2g);
          acc[mi][0][i] *= zt; acc[mi][1][i] *= zt;
        }
    }
    stage_T(acc, st, r, lh);
  }
  __syncthreads();
  if (t_dst) flush_T(st, t_dst, lane);
}

DI void phase_inproj(const Params& p, int L, int* ctr, int* s_item, unsigned char* smem) {
  const bf16_t* Bt = p.winT() + (size_t)L * NINP * DM;
  for (;;) {
    int mt, nt;
    if (!xcd_tile(ctr, s_item, 128, 24, mt, nt)) break;
    f32x16 acc[4][2];
    ARowMajor af{p.xb(), DM, mt * 256};
    gemm_big(acc, af, Bt, DM, nt * 128, 16, smem, (PROBE_DRY && ctr >= p.ctr() + 512) ? PROBE_DM : 0);
    if (!(PROBE_DRY && ctr >= p.ctr() + 512)) epi_inproj(acc, mt * 256, nt * 128, p, smem);
  }
}

DI f32x16 qk_block(const bf16_t* sK, int ldk, int kb, const bf16x8 (&qf)[4], int r, int lh, float cinit = 0.f) {
  f32x16 s;
#pragma unroll
  for (int i = 0; i < 16; ++i) s[i] = cinit;
  const bf16_t* kp = sK + (kb * 32 + r) * ldk + 8 * lh;
#pragma unroll
  for (int s4 = 0; s4 < 4; ++s4) {
    bf16x8 a = *(const bf16x8*)(kp + 16 * s4);
    s = MFMA32(a, qf[s4], s);
  }
  return s;
}
DI void pv_block(f32x16 (&o)[2], const bf16_t* sVT, int ldv, int kb, const f32x16& pm, int r, int lh) {
#pragma unroll
  for (int sp = 0; sp < 2; ++sp) {
    uint4 pk;
    pk.x = pack2(pm[8 * sp + 0], pm[8 * sp + 1]);
    pk.y = pack2(pm[8 * sp + 2], pm[8 * sp + 3]);
    pk.z = pack2(pm[8 * sp + 4], pm[8 * sp + 5]);
    pk.w = pack2(pm[8 * sp + 6], pm[8 * sp + 7]);
    bf16x8 pb = __builtin_bit_cast(bf16x8, pk);
#pragma unroll
    for (int db = 0; db < 2; ++db) {
      const bf16_t* vp = sVT + (db * 32 + r) * ldv + kb * 32 + 16 * sp + 4 * lh;
      uint2 lo = *(const uint2*)vp;
      uint2 hi = *(const uint2*)(vp + 8);
      uint4 av = make_uint4(lo.x, lo.y, hi.x, hi.y);
      o[db] = MFMA32(__builtin_bit_cast(bf16x8, av), pb, o[db]);
    }
  }
}

template <int MODE>
DI void nsa_item(const Params& p, int item, unsigned char* smem, int u_lo = 0, int u_hi = 3) {
  const int tid = tid_(), lane = tid & 63, w = tid >> 6, r = lane & 31, lh = lane >> 5;
  const int tt = 31 - (item >> 4), bg = item & 15, b = bg >> 1, g = bg & 1;
  const int t0 = tt * 128;
  const int tq = t0 + w * 32 + r;
  const unsigned tok = (unsigned)b * SEQ + tq;
  bf16_t* sK = (bf16_t*)smem;
  bf16_t* sV = (bf16_t*)(smem + 2 * 64 * LDT * 2);
  float* impL = (float*)(smem + 4 * 64 * LDT * 2);
  u64* s_sel = (u64*)(smem + 4 * 64 * LDT * 2);

  const bf16_t* Kb; const bf16_t* Vb; int ldkg, ldvg;
  if (MODE == 0) { Kb = p.kwin() + (size_t)b * SEQ * 128 + g * 64; ldkg = 128; Vb = p.vwT() + (size_t)(b * 2 + g) * 64 * SEQ; ldvg = SEQ; }
  else if (MODE == 1) { Kb = p.kc() + (size_t)(b * 2 + g) * 256 * 64; ldkg = 64; Vb = p.vcT() + (size_t)(b * 2 + g) * 64 * 256; ldvg = 256; }
  else { Kb = p.kslc() + (size_t)b * SEQ * 128 + g * 64; ldkg = 128; Vb = p.vslT() + (size_t)(b * 2 + g) * 64 * SEQ; ldvg = SEQ; }

  u64 mysel = 0, umask = 0;
  int ntiles, kfirst;
  if (MODE == 0) { int klo = t0 - 512; if (klo < 0) klo = 0; kfirst = klo; ntiles = (t0 + 64 - klo) / 64 + 1; }
  else if (MODE == 1) {
    kfirst = 0; int nmax = (t0 + 96) >> 4; ntiles = nmax / 64 + 1; if (ntiles > 4) ntiles = 4;
    for (int i = tid; i < 128 * 65; i += 256) impL[i] = 0.f;
  } else {
    if (tid == 0) s_sel[128] = 0ull;
    __syncthreads();
    if (tid < 128) { u64 sv = p.sel()[(size_t)(b * 2 + g) * SEQ + t0 + tid]; s_sel[tid] = sv; atomicOr(&s_sel[128], sv); }
    __syncthreads();
    mysel = s_sel[w * 32 + r];
    umask = s_sel[128];
    const int jmax = (t0 + 127) >> 6;
    umask &= (jmax >= 63) ? ~0ull : ((1ull << (jmax + 1)) - 1ull);
    umask |= 1ull;
    ntiles = __popcll(umask);
    kfirst = 0;
  }

  constexpr int TP = (MODE == 1) ? 1 : 2;
  const int lrow = tid >> 3, lch = tid & 7;
  const bf16_t* kg0 = Kb + (size_t)lrow * ldkg + lch * 8;
  const bf16_t* kg1 = Kb + (size_t)(lrow + 32) * ldkg + lch * 8;
  const bf16_t* vg0 = Vb + (size_t)lrow * ldvg + lch * 8;
  const bf16_t* vg1 = Vb + (size_t)(lrow + 32) * ldvg + lch * 8;
  const int so0 = lrow * LDT + lch * 8, so1 = (lrow + 32) * LDT + lch * 8;
  uint4 rk0, rk1, rv0, rv1, rk2, rk3, rv2, rv3;
#define KV_GLOAD(keyA, keyB)                                   \
  {                                                            \
    rk0 = *(const uint4*)(kg0 + (size_t)(keyA) * ldkg);        \
    rk1 = *(const uint4*)(kg1 + (size_t)(keyA) * ldkg);        \
    rv0 = *(const uint4*)(vg0 + (keyA));                       \
    rv1 = *(const uint4*)(vg1 + (keyA));                       \
    if (TP == 2) {                                             \
      rk2 = *(const uint4*)(kg0 + (size_t)(keyB) * ldkg);      \
      rk3 = *(const uint4*)(kg1 + (size_t)(keyB) * ldkg);      \
      rv2 = *(const uint4*)(vg0 + (keyB));                     \
      rv3 = *(const uint4*)(vg1 + (keyB));                     \
    }                                                          \
  }
#define KV_SSTORE(stg)                                                     \
  {                                                                        \
    bf16_t* bK_ = sKV + ((stg) * TP) * 2 * 64 * LDT;                       \
    *(uint4*)(bK_ + so0) = rk0;                                            \
    *(uint4*)(bK_ + so1) = rk1;                                            \
    *(uint4*)(bK_ + 64 * LDT + so0) = rv0;                                 \
    *(uint4*)(bK_ + 64 * LDT + so1) = rv1;                                 \
    if (TP == 2) {                                                         \
      *(uint4*)(bK_ + 2 * 64 * LDT + so0) = rk2;                           \
      *(uint4*)(bK_ + 2 * 64 * LDT + so1) = rk3;                           \
      *(uint4*)(bK_ + 3 * 64 * LDT + so0) = rv2;                           \
      *(uint4*)(bK_ + 3 * 64 * LDT + so1) = rv3;                           \
    }                                                                      \
  }
  bf16_t* sKV = (bf16_t*)smem;

#pragma unroll 1
  for (int u = u_lo; u < u_hi; ++u) {
    const int hcol = (g * 3 + u) * 64;
    bf16x8 qf[4];
#pragma unroll
    for (int s = 0; s < 4; ++s) qf[s] = *(const bf16x8*)(p.qnsa() + (size_t)tok * 384 + hcol + 16 * s + 8 * lh);
    f32x16 o[2];
#pragma unroll
    for (int db = 0; db < 2; ++db)
#pragma unroll
      for (int i = 0; i < 16; ++i) o[db][i] = 0.f;
    float m = -1e30f, l = 0.f, invl = 0.f, carry = 0.f;

    const int npass = (MODE == 1) ? 2 : 1;
#pragma unroll 1
    for (int pass = 0; pass < npass; ++pass) {
      u64 rem = umask;
      int ka = kfirst, kb2 = kfirst + 64;
      bool vb = (TP == 2) && (ntiles > 1);
      if (MODE == 2) {
        rem &= rem - 1;
        vb = rem != 0ull;
        kb2 = vb ? (__builtin_ctzll(rem) << 6) : ka;
        rem &= rem - 1;
      }
      const int npairs = (ntiles + TP - 1) / TP;
      KV_GLOAD(ka, kb2);
      KV_SSTORE(0);
      __syncthreads();
#pragma unroll 1
      for (int ti = 0; ti < npairs; ++ti) {
        int na = (TP == 2 ? kb2 : ka) + 64, nb = na + 64;
        bool nvb = (TP == 2) && ((ti + 1) * 2 + 1 < ntiles);
        if (MODE == 2) {
          na = rem ? (__builtin_ctzll(rem) << 6) : 0; rem &= rem - 1;
          nvb = rem != 0ull;
          nb = nvb ? (__builtin_ctzll(rem) << 6) : na;
          rem &= rem - 1;
        }
        if (MODE == 0 && !nvb) nb = na;
        const bool more = ti + 1 < npairs;
        if (more) KV_GLOAD(na, nb);
#pragma unroll 1
        for (int half = 0; half < TP; ++half) {
        if (half == 1 && !vb) break;
        const int key_cur = half ? kb2 : ka;
        const bf16_t* cK = sKV + (((ti & 1) * TP + half) * 2) * 64 * LDT;
        const bf16_t* cV = cK + 64 * LDT;
        int lo, hi;
        if (MODE == 0) { hi = tq - key_cur; lo = tq - 511 - key_cur; }
        else if (MODE == 1) { hi = ((tq - 31) >> 4) - key_cur; lo = 0; }
        else { const int j = key_cur >> 6; hi = ((mysel >> j) & 1ull) ? (tq - key_cur) : -1; lo = 0; }
        const bool skip = (MODE != 1) && __all((hi < 0) || (lo > 63));
        const bool full = __all((lo <= 0) && (hi >= 63));
        const bool rowvalid = hi >= 0;
        const bool rowonly = !full && __all((hi < 0) || ((lo <= 0) && (hi >= 63)));
        if (!skip) {
          const int lo2 = lo - 4 * lh, hi2 = hi - 4 * lh;
          f32x16 S[2];
          bool fastdone = false;
          if (MODE != 1 && (full || rowonly) && __all(!rowvalid || m > -1e29f)) {
            const float cinit = rowvalid ? -m : -1e30f;
            S[0] = qk_block(cK, LDT, 0, qf, r, lh, cinit);
            S[1] = qk_block(cK, LDT, 1, qf, r, lh, cinit);
            float mxs = -1e30f;
#pragma unroll
            for (int kb = 0; kb < 2; ++kb)
#pragma unroll
              for (int i = 0; i < 16; ++i) mxs = fmaxf(mxs, S[kb][i]);
            if (__all(mxs <= 8.f)) {
              float rs = 0.f;
#pragma unroll
              for (int kb = 0; kb < 2; ++kb)
#pragma unroll
                for (int i = 0; i < 16; ++i) {
                  float pv = __builtin_amdgcn_exp2f(S[kb][i]);
                  S[kb][i] = pv;
                  rs += pv;
                }
              l += rs;
              pv_block(o, cV, LDT, 0, S[0], r, lh);
              pv_block(o, cV, LDT, 1, S[1], r, lh);
              fastdone = true;
            }
          }
          if (!fastdone) {
          S[0] = qk_block(cK, LDT, 0, qf, r, lh);
          S[1] = qk_block(cK, LDT, 1, qf, r, lh);
          if (!full && !rowonly) {
            asm volatile("" ::: "memory");
#pragma unroll
            for (int kb = 0; kb < 2; ++kb)
#pragma unroll
              for (int i = 0; i < 16; ++i) {
                const int c = kb * 32 + (i & 3) + 8 * (i >> 2);
                S[kb][i] = (c >= lo2 && c <= hi2) ? S[kb][i] : -1e30f;
              }
          }
          float mx = -1e30f;
#pragma unroll
          for (int kb = 0; kb < 2; ++kb)
#pragma unroll
            for (int i = 0; i < 16; ++i) mx = fmaxf(mx, S[kb][i]);
          if (rowonly) mx = rowvalid ? mx : -1e30f;
          if (MODE == 1 && pass == 1) {
            float mref = fmaxf(m, -1e20f);
            if (rowonly) mref = rowvalid ? mref : 1e30f;
#pragma unroll
            for (int kb = 0; kb < 2; ++kb)
#pragma unroll
              for (int i = 0; i < 16; ++i) S[kb][i] = __builtin_amdgcn_exp2f(S[kb][i] - mref) * invl;
#pragma unroll
            for (int kb = 0; kb < 2; ++kb)
#pragma unroll
              for (int gq = 0; gq < 4; ++gq) {
                float a = 2.f * (S[kb][4 * gq] + S[kb][4 * gq + 1] + S[kb][4 * gq + 2]) + S[kb][4 * gq + 3];
                float bq = S[kb][4 * gq + 3];
                float recv = xor32(bq);
                float tot;
                if (lh == 1) tot = a + recv;
                else { tot = a + carry; carry = recv; }
                const int j = (key_cur >> 2) + 8 * kb + 2 * gq + lh;
                impL[(w * 32 + r) * 65 + j] += tot;
              }
          } else {
            mx = fmaxf(mx, xor32(mx));
            const float mnew = fmaxf(m, mx);
            const float alpha = __builtin_amdgcn_exp2f(m - mnew);
            m = mnew;
            float mref = fmaxf(mnew, -1e20f);
            if (rowonly) mref = rowvalid ? mref : 1e30f;
            float rs = 0.f;
#pragma unroll
            for (int kb = 0; kb < 2; ++kb)
#pragma unroll
              for (int i = 0; i < 16; ++i) {
                float pv = __builtin_amdgcn_exp2f(S[kb][i] - mref);
                S[kb][i] = pv;
                rs += pv;
              }
            l = l * alpha + rs;
            if (MODE != 1) {
#pragma unroll
              for (int db = 0; db < 2; ++db)
#pragma unroll
                for (int i = 0; i < 16; ++i) o[db][i] *= alpha;
            }
          }
          if (!(MODE == 1 && pass == 0)) {
            pv_block(o, cV, LDT, 0, S[0], r, lh);
            pv_block(o, cV, LDT, 1, S[1], r, lh);
          }
          }
        }
        }
        if (more) KV_SSTORE((ti + 1) & 1);
        __syncthreads();
        ka = na; kb2 = nb; vb = nvb;
      }
      if (MODE == 1 && pass == 0) {
        float lt = l + xor32(l);
        invl = lt > 0.f ? 1.f / lt : 0.f;
      }
    }

    if (MODE == 1) {
      if (lh == 0) impL[(w * 32 + r) * 65 + 16 * ntiles] += carry;
#pragma unroll
      for (int db = 0; db < 2; ++db)
#pragma unroll
        for (int gq = 0; gq < 4; ++gq) {
          uint2 uu;
          uu.x = pack2(o[db][4 * gq], o[db][4 * gq + 1]);
          uu.y = pack2(o[db][4 * gq + 2], o[db][4 * gq + 3]);
          *(uint2*)(p.ocmp() + (size_t)tok * 384 + hcol + db * 32 + 8 * gq + 4 * lh) = uu;
        }
    } else {
      float lt = l + xor32(l);
      const float il = lt > 0.f ? 1.f / lt : 0.f;
      float g0 = 0.f, g1 = 0.f, g2 = 0.f;
      if (MODE == 2) {
        const float* gp = p.gates() + (size_t)tok * 18 + (g * 3 + u) * 3;
        g0 = gp[0]; g1 = gp[1]; g2 = gp[2];
      }
#pragma unroll
      for (int db = 0; db < 2; ++db)
#pragma unroll
        for (int gq = 0; gq < 4; ++gq) {
          const int d0 = db * 32 + 8 * gq + 4 * lh;
          float v0 = o[db][4 * gq] * il, v1 = o[db][4 * gq + 1] * il, v2 = o[db][4 * gq + 2] * il, v3 = o[db][4 * gq + 3] * il;
          bf16_t* yp = (MODE == 0) ? (p.owin() + (size_t)tok * 384 + hcol + d0) : (p.y() + (size_t)tok * DM + 640 + hcol + d0);
          if (MODE == 2) {
            uint2 oc = *(const uint2*)(p.ocmp() + (size_t)tok * 384 + hcol + d0);
            uint2 ow = *(const uint2*)(p.owin() + (size_t)tok * 384 + hcol + d0);
            v0 = g0 * bf2f((bf16_t)(oc.x & 0xffff)) + g1 * v0 + g2 * bf2f((bf16_t)(ow.x & 0xffff));
            v1 = g0 * bf2f((bf16_t)(oc.x >> 16)) + g1 * v1 + g2 * bf2f((bf16_t)(ow.x >> 16));
            v2 = g0 * bf2f((bf16_t)(oc.y & 0xffff)) + g1 * v2 + g2 * bf2f((bf16_t)(ow.y & 0xffff));
            v3 = g0 * bf2f((bf16_t)(oc.y >> 16)) + g1 * v3 + g2 * bf2f((bf16_t)(ow.y >> 16));
          }
          uint2 uu; uu.x = pack2(v0, v1); uu.y = pack2(v2, v3);
          *(uint2*)yp = uu;
        }
    }
  }
#undef KV_GLOAD
#undef KV_SSTORE

  if (MODE == 1) {
    __syncthreads();
#pragma unroll 1
    for (int q = 0; q < 32; ++q) {
      const int row = w * 32 + q;
      const int t = t0 + row;
      const int cur = t >> 6;
      u64 msk;
      if (cur < 16) {
        msk = (1ull << (cur + 1)) - 1ull;
      } else {
        float v = impL[row * 65 + lane];
        float sc = (lane <= cur) ? ((lane == 0 || lane == cur || lane == cur - 1) ? 1e6f : v) : -1.f;
        const unsigned ub = __float_as_uint(sc);
        const unsigned key = (ub & 0x80000000u) ? ~ub : (ub | 0x80000000u);
        unsigned T = 0u;
#pragma unroll 1
        for (int bit = 31; bit >= 0; --bit) {
          const unsigned cand = T | (1u << bit);
          if (__popcll(__ballot(key >= cand)) >= 16) T = cand;
        }
        msk = __ballot(key > T);
        u64 eq = __ballot(key == T);
        int remaining = 16 - __popcll(msk);
        while (remaining > 0 && eq) { msk |= eq & (~eq + 1ull); eq &= eq - 1ull; --remaining; }
      }
      if (lane == 0) p.sel()[(size_t)(b * 2 + g) * SEQ + t] = msk;
    }
  }
}

DI void retkv_item(const Params& p, int item) {
  const int tid = tid_(), lane = tid & 63, w = tid >> 6, r = lane & 31, lh = lane >> 5;
  const int n = item & 31, bh = item >> 5;
  const int eb = w >> 1, db = w & 1;
  f32x16 acc;
#pragma unroll
  for (int i = 0; i < 16; ++i) acc[i] = 0.f;
  const bf16_t* ap = p.vrT() + (size_t)(bh * 64 + eb * 32 + r) * SEQ + n * 128 + 8 * lh;
  const bf16_t* bp = p.kzT() + (size_t)(bh * 64 + db * 32 + r) * SEQ + n * 128 + 8 * lh;
#pragma unroll
  for (int s = 0; s < 8; ++s) {
    bf16x8 a = *(const bf16x8*)(ap + 16 * s);
    bf16x8 bb = *(const bf16x8*)(bp + 16 * s);
    acc = MFMA32(a, bb, acc);
  }
  float* dst = p.kvT() + (size_t)item * 4096;
#pragma unroll
  for (int i = 0; i < 16; ++i) dst[(eb * 32 + crow(i, lh)) * 64 + db * 32 + r] = acc[i];
}

DI void retscan_item(const Params& p, int item) {
  const int bh = item >> 4, part = item & 15, hd = bh % 6;
  const int idx = part * 256 + tid_();
  const float gc = exp2f(128.f * ret_l2g(hd));
  float kv[32];
#pragma unroll
  for (int n = 0; n < 32; ++n) kv[n] = p.kvT()[(size_t)(bh * 32 + n) * 4096 + idx];
  float st = 0.f;
#pragma unroll
  for (int n = 0; n < 32; ++n) {
    p.RT()[(size_t)(bh * 32 + n) * 4096 + idx] = f2bf(st);
    st = fmaf(gc, st, kv[n]);
  }
}

DI void retout_item(const Params& p, int L, int item, unsigned char* smem) {
  const int tid = tid_(), lane = tid & 63, w = tid >> 6, r = lane & 31, lh = lane >> 5;
  const int n = item & 31, bh = item >> 5, hd = bh % 6, b = bh / 6;
  constexpr int LDV2 = 136;
  bf16_t* sK = (bf16_t*)smem;
  bf16_t* sV = (bf16_t*)(smem + 128 * LDT * 2);
  const size_t tok0 = (size_t)b * SEQ + n * 128;
  {
    const int lrow = tid >> 3, lch = tid & 7;
#pragma unroll
    for (int c = 0; c < 4; ++c)
      *(uint4*)(sK + (lrow + 32 * c) * LDT + lch * 8) = *(const uint4*)(p.kret() + (tok0 + lrow + 32 * c) * 384 + hd * 64 + lch * 8);
    const int vrow = tid >> 4, vch = tid & 15;
#pragma unroll
    for (int c = 0; c < 4; ++c)
      *(uint4*)(sV + (vrow + 16 * c) * LDV2 + vch * 8) = *(const uint4*)(p.vrT() + (size_t)(bh * 64 + vrow + 16 * c) * SEQ + n * 128 + vch * 8);
  }
  const int iq = w * 32 + r;
  const size_t tok = tok0 + iq;
  bf16x8 qf[4];
#pragma unroll
  for (int s = 0; s < 4; ++s) qf[s] = *(const bf16x8*)(p.qret() + tok * 384 + hd * 64 + 16 * s + 8 * lh);
  const float l2g = ret_l2g(hd);
  f32x16 o[2];
#pragma unroll
  for (int db = 0; db < 2; ++db)
#pragma unroll
    for (int i = 0; i < 16; ++i) o[db][i] = 0.f;
  const bf16_t* rt = p.RT() + (size_t)item * 4096;
#pragma unroll
  for (int db = 0; db < 2; ++db)
#pragma unroll
    for (int s = 0; s < 4; ++s) {
      bf16x8 a = *(const bf16x8*)(rt + (db * 32 + r) * 64 + 16 * s + 8 * lh);
      o[db] = MFMA32(a, qf[s], o[db]);
    }
  const float xi = exp2f((float)(iq + 1) * l2g);
#pragma unroll
  for (int db = 0; db < 2; ++db)
#pragma unroll
    for (int i = 0; i < 16; ++i) o[db][i] *= xi;
  __syncthreads();
  for (int kb = 0; kb <= w; ++kb) {
    f32x16 S = qk_block(sK, LDT, kb, qf, r, lh);
#pragma unroll
    for (int i = 0; i < 16; ++i) {
      const int diff = iq - (kb * 32 + crow(i, lh));
      S[i] = diff >= 0 ? S[i] * __builtin_amdgcn_exp2f((float)diff * l2g) : 0.f;
    }
    pv_block(o, sV, LDV2, kb, S, r, lh);
  }
  float sm = 0.f;
#pragma unroll
  for (int db = 0; db < 2; ++db)
#pragma unroll
    for (int i = 0; i < 16; ++i) sm += o[db][i];
  sm += xor32(sm);
  const float mu = sm * (1.f / 64.f);
  float vs = 0.f;
#pragma unroll
  for (int db = 0; db < 2; ++db)
#pragma unroll
    for (int i = 0; i < 16; ++i) { float dd = o[db][i] - mu; vs += dd * dd; }
  vs += xor32(vs);
  const float rstd = rsqrtf(vs * (1.f / 64.f) + 1e-5f);
  const float* gng = p.gn_g + (size_t)L * 384 + hd * 64;
#pragma unroll
  for (int db = 0; db < 2; ++db)
#pragma unroll
    for (int gq = 0; gq < 4; ++gq) {
      const int d0 = db * 32 + 8 * gq + 4 * lh;
      uint2 sg = *(const uint2*)(p.gret() + tok * 384 + hd * 64 + d0);
      float4 gg = *(const float4*)(gng + d0);
      float v0 = (o[db][4 * gq] - mu) * rstd * gg.x * bf2f((bf16_t)(sg.x & 0xffff));
      float v1 = (o[db][4 * gq + 1] - mu) * rstd * gg.y * bf2f((bf16_t)(sg.x >> 16));
      float v2 = (o[db][4 * gq + 2] - mu) * rstd * gg.z * bf2f((bf16_t)(sg.y & 0xffff));
      float v3 = (o[db][4 * gq + 3] - mu) * rstd * gg.w * bf2f((bf16_t)(sg.y >> 16));
      uint2 uu; uu.x = pack2(v0, v1); uu.y = pack2(v2, v3);
      *(uint2*)(p.y() + tok * DM + 256 + hd * 64 + d0) = uu;
    }
}

DI void pool_item(const Params& p, int L, int item, unsigned char* smem) {
  const int tid = tid_(), lane = tid & 63, w = tid >> 6, r = lane & 31, lh = lane >> 5;
  const int gi = item & 3, tt = (item >> 2) & 63, b = item >> 8;
  const int t0 = tt * 64;
  float* sv = (float*)smem;
  bf16_t* am = (bf16_t*)(smem + 79 * 65 * 4 + 4);
  for (int idx = tid; idx < 79 * 8; idx += 256) {
    const int rr = idx >> 3, ch = idx & 7, ts = t0 - 15 + rr;
    uint4 u = make_uint4(0, 0, 0, 0);
    if (ts >= 0) u = *(const uint4*)(p.vpool() + ((size_t)b * SEQ + ts) * 256 + gi * 64 + ch * 8);
    float* d = sv + rr * 65 + ch * 8;
    d[0] = bf2f((bf16_t)(u.x & 0xffff)); d[1] = bf2f((bf16_t)(u.x >> 16)); d[2] = bf2f((bf16_t)(u.y & 0xffff)); d[3] = bf2f((bf16_t)(u.y >> 16));
    d[4] = bf2f((bf16_t)(u.z & 0xffff)); d[5] = bf2f((bf16_t)(u.z >> 16)); d[6] = bf2f((bf16_t)(u.w & 0xffff)); d[7] = bf2f((bf16_t)(u.w >> 16));
  }
  __syncthreads();
  const int win = 2 << gi;
  for (int idx = tid; idx < 4096; idx += 256) {
    const int tl = idx >> 6, c = idx & 63, t = t0 + tl;
    int lo = t + 1 - win; if (lo < 0) lo = 0;
    float s = 0.f;
    for (int u = lo; u <= t; ++u) s += sv[(u - t0 + 15) * 65 + c];
    am[tl * 72 + c] = f2bf(s / (float)(t + 1 - lo) - sv[(tl + 15) * 65 + c]);
  }
  __syncthreads();
  const int mb = w >> 1, nb = w & 1;
  f32x16 acc;
#pragma unroll
  for (int i = 0; i < 16; ++i) acc[i] = 0.f;
  const bf16_t* bp = p.pwT() + ((size_t)(L * 4 + gi) * 64 + nb * 32 + r) * 64 + 8 * lh;
#pragma unroll
  for (int s = 0; s < 4; ++s) {
    bf16x8 a = *(const bf16x8*)(am + (mb * 32 + r) * 72 + 16 * s + 8 * lh);
    bf16x8 bb = *(const bf16x8*)(bp + 16 * s);
    acc = MFMA32(a, bb, acc);
  }
  const int d = nb * 32 + r;
  const float scl = p.pool_scale[L * 256 + gi * 64 + d];
#pragma unroll
  for (int i = 0; i < 16; ++i)
    p.y()[((size_t)b * SEQ + t0 + mb * 32 + crow(i, lh)) * DM + gi * 64 + d] = f2bf(acc[i] * scl);
}

DI void compress_item(const Params& p, int L, int item, unsigned char* smem) {
  const int tid = tid_(), lane = tid & 63, w = tid >> 6, r = lane & 31, lh = lane >> 5;
  const int which = item >> 7, rest = item & 127, bg = rest >> 3, q = rest & 7, b = bg >> 1, g = bg & 1;
  const int i0 = q * 32;
  constexpr int LDC = 136;
  bf16_t* sA = (bf16_t*)smem;
  bf16_t* sB = (bf16_t*)(smem + 32 * LDC * 2);
  const bf16_t* src = (which ? p.vcmp() : p.kcmp()) + (size_t)b * SEQ * 128 + g * 64;
  const bf16_t* w1 = p.w1T() + (size_t)(L * 2 + which) * 128 * 2048;
  uint4 ra0, ra1, rb0, rb1, rb2, rb3, rb4, rb5, rb6, rb7;
  const int c16 = tid & 15, rowq = tid >> 4;
#define CLA(ra, c, it)                                                                                   \
  {                                                                                                      \
    const int ci = i0 + rowq + 16 * (c);                                                                 \
    const int l = 2 * (it) + (c16 >> 3);                                                                 \
    ra = (ci <= 254) ? *(const uint4*)(src + (size_t)(16 * ci + l) * 128 + (c16 & 7) * 8) : make_uint4(0, 0, 0, 0); \
  }
#define CLB(rb, c, it) { rb = *(const uint4*)(w1 + (size_t)(rowq + 16 * (c)) * 2048 + (it) * 128 + c16 * 8); }
#define CLOAD(it) { CLA(ra0, 0, it) CLA(ra1, 1, it) CLB(rb0, 0, it) CLB(rb1, 1, it) CLB(rb2, 2, it) CLB(rb3, 3, it) CLB(rb4, 4, it) CLB(rb5, 5, it) CLB(rb6, 6, it) CLB(rb7, 7, it) }
#define CSA(ra, c) { *(uint4*)(sA + (rowq + 16 * (c)) * LDC + c16 * 8) = ra; }
#define CSB(rb, c) { *(uint4*)(sB + (rowq + 16 * (c)) * LDC + c16 * 8) = rb; }
#define CSTORE() { CSA(ra0, 0) CSA(ra1, 1) CSB(rb0, 0) CSB(rb1, 1) CSB(rb2, 2) CSB(rb3, 3) CSB(rb4, 4) CSB(rb5, 5) CSB(rb6, 6) CSB(rb7, 7) }
  f32x16 acc;
#pragma unroll
  for (int i = 0; i < 16; ++i) acc[i] = 0.f;
  CLOAD(0);
  CSTORE();
  __syncthreads();
#pragma unroll 1
  for (int it = 0; it < 16; ++it) {
    const int i1 = (it + 1 < 16) ? it + 1 : 15;
    CLOAD(i1);
#pragma unroll
    for (int s = 0; s < 8; ++s) {
      bf16x8 a = *(const bf16x8*)(sA + r * LDC + 16 * s + 8 * lh);
      bf16x8 bb = *(const bf16x8*)(sB + (32 * w + r) * LDC + 16 * s + 8 * lh);
      acc = MFMA32(a, bb, acc);
    }
    __syncthreads();
    CSTORE();
    __syncthreads();
  }
#undef CLA
#undef CLB
#undef CLOAD
#undef CSA
#undef CSB
#undef CSTORE
  bf16_t* Hs = (bf16_t*)smem;
  {
    const int col = 32 * w + r;
    const float* c1 = p.c1() + (size_t)(L * 2 + which) * 64 * 128;
    float cb = ((which ? p.cb1_v : p.cb1_k) + (size_t)L * 128)[col];
    for (int kb = 0; kb < 64; ++kb) cb += c1[kb * 128 + col];
#pragma unroll
    for (int i = 0; i < 16; ++i) Hs[crow(i, lh) * LDC + col] = f2bf(gelu_tanh(acc[i] + cb));
  }
  __syncthreads();
  if (w == 0) {
    f32x16 o[2];
#pragma unroll
    for (int nb = 0; nb < 2; ++nb)
#pragma unroll
      for (int i = 0; i < 16; ++i) o[nb][i] = 0.f;
    const bf16_t* w2 = p.w2T() + (size_t)(L * 2 + which) * 64 * 128;
#pragma unroll
    for (int s = 0; s < 8; ++s) {
      bf16x8 a = *(const bf16x8*)(Hs + r * LDC + 16 * s + 8 * lh);
#pragma unroll
      for (int nb = 0; nb < 2; ++nb) {
        bf16x8 bb = *(const bf16x8*)(w2 + (nb * 32 + r) * 128 + 16 * s + 8 * lh);
        o[nb] = MFMA32(a, bb, o[nb]);
      }
    }
    if (which == 0) {
#pragma unroll
      for (int i = 0; i < 16; ++i) {
        const int ci = i0 + crow(i, lh);
        float v1 = 0.f, v2 = 0.f;
        if (ci <= 254) {
          float2 cs = p.tab()[((size_t)b * SEQ + 16 * ci + 31) * 32 + r];
          float x1 = o[0][i], x2 = o[1][i];
          v1 = x1 * cs.x - x2 * cs.y; v2 = x2 * cs.x + x1 * cs.y;
        }
        p.kc()[((size_t)bg * 256 + ci) * 64 + r] = f2bf(v1);
        p.kc()[((size_t)bg * 256 + ci) * 64 + 32 + r] = f2bf(v2);
      }
    } else {
#pragma unroll
      for (int nb = 0; nb < 2; ++nb)
#pragma unroll
        for (int gq = 0; gq < 4; ++gq) {
          uint2 uu;
          uu.x = pack2(o[nb][4 * gq], o[nb][4 * gq + 1]);
          uu.y = pack2(o[nb][4 * gq + 2], o[nb][4 * gq + 3]);
          *(uint2*)(p.vcT() + ((size_t)bg * 64 + nb * 32 + r) * 256 + i0 + 8 * gq + 4 * lh) = uu;
        }
    }
  }
}

DI void phase_mixA(const Params& p, int L, int* ctr, int* s_item, unsigned char* smem) {
  for (;;) {
    int item = next_item(ctr, s_item);
    if (item >= 256 + 1536 + 1536 + 2048) break;
    if (item < 256) compress_item(p, L, item, smem);
    else if (item < 256 + 1536) { const int q = item - 256, uu = q % 3; nsa_item<0>(p, q / 3, smem, uu, uu + 1); }
    else if (item < 256 + 1536 + 1536) retkv_item(p, item - 256 - 1536);
    else pool_item(p, L, item - 256 - 1536 - 1536, smem);
  }
}
DI void phase_mixB(const Params& p, int L, int* ctr, int* s_item, unsigned char* smem) {
  for (;;) {
    int item = next_item(ctr, s_item);
    if (item >= 512 + 768) break;
    if (item < 512) nsa_item<1>(p, item, smem);
    else retscan_item(p, item - 512);
  }
}
DI void phase_mixC(const Params& p, int L, int* ctr, int* s_item, unsigned char* smem) {
  for (;;) {
    int item = next_item(ctr, s_item);
    if (item >= 1536 + 1536) break;
    if (item < 1536) { const int uu = item % 3; nsa_item<2>(p, item / 3, smem, uu, uu + 1); }
    else retout_item(p, L, item - 1536, smem);
  }
}

DI void epi_resid(const f32x16 (&acc)[4][2], int m0, int n0, const Params& p, int mode, const float2* stats, const float* lg, const float* lb,
                  unsigned char* smem) {
  const int tid = tid_(), lane = tid & 63, w = tid >> 6, wm = w >> 1, wn = w & 1, r = lane & 31, lh = lane >> 5;
  constexpr int LDF = 68;
  float* st = (float*)(smem + w * (64 * LDF * 4));
  const int colbase = n0 + wn * 64;
  const int rr = lane >> 4, ch = lane & 15;
  const float4 gg = *(const float4*)(lg + colbase + ch * 4);
  const float4 bb = *(const float4*)(lb + colbase + ch * 4);
#pragma unroll
  for (int half = 0; half < 2; ++half) {
#pragma unroll
    for (int mh = 0; mh < 2; ++mh)
#pragma unroll
      for (int ni = 0; ni < 2; ++ni)
#pragma unroll
        for (int i = 0; i < 16; ++i) st[(mh * 32 + crow(i, lh)) * LDF + ni * 32 + r] = acc[half * 2 + mh][ni][i];
    __syncthreads();
#pragma unroll 8
    for (int k = 0; k < 16; ++k) {
      const int lrow = k * 4 + rr;
      const size_t row = (size_t)(m0 + wm * 128 + half * 64 + lrow);
      const float4 a = *(const float4*)(st + lrow * LDF + ch * 4);
      float* zp = p.z + row * DM + colbase + ch * 4;
      float4 res;
      if (mode == 0) res = *(const float4*)(p.x + row * DM + colbase + ch * 4);
      else {
        const float2 sv = stats[row];
        const float4 zz = *(const float4*)zp;
        res.x = (zz.x - sv.x) * sv.y * gg.x + bb.x; res.y = (zz.y - sv.x) * sv.y * gg.y + bb.y;
        res.z = (zz.z - sv.x) * sv.y * gg.z + bb.z; res.w = (zz.w - sv.x) * sv.y * gg.w + bb.w;
      }
      *(float4*)zp = make_float4(ALPHA * res.x + a.x, ALPHA * res.y + a.y, ALPHA * res.z + a.z, ALPHA * res.w + a.w);
    }
    __syncthreads();
  }
}

DI void phase_outproj(const Params& p, int L, int* ctr, int* s_item, unsigned char* smem) {
  const bf16_t* Bt = p.woutT() + (size_t)L * DM * DM;
  for (;;) {
    int mt, nt;
    if (!xcd_tile(ctr, s_item, 128, 8, mt, nt)) break;
    f32x16 acc[4][2];
    ARowMajor af{p.y(), DM, mt * 256};
    gemm_big(acc, af, Bt, DM, nt * 128, 16, smem);
    epi_resid(acc, mt * 256, nt * 128, p, L == 0 ? 0 : 1, p.stats2(), p.ln2g + (size_t)(L ? L - 1 : 0) * DM, p.ln2b + (size_t)(L ? L - 1 : 0) * DM, smem);
  }
}

DI void phase_ffn2(const Params& p, int L, int* ctr, int* s_item, unsigned char* smem) {
  const bf16_t* Bt = p.wdT() + (size_t)L * DM * DFF;
  for (;;) {
    int mt, nt;
    if (!xcd_tile(ctr, s_item, 128, 8, mt, nt)) break;
    f32x16 acc[4][2];
    ARowMajor af{p.act(), DFF, mt * 256};
    gemm_big(acc, af, Bt, DFF, nt * 128, 44, smem);
    epi_resid(acc, mt * 256, nt * 128, p, 1, p.stats1(), p.ln1g + (size_t)L * DM, p.ln1b + (size_t)L * DM, smem);
  }
}

struct AFfn1 {
  const bf16_t* xb; int tbase;
  DI const bf16_t* operator()(int row, int it) const {
    int ts = tbase + row;
    return (ts >= 0 && ts < SEQ) ? xb + (size_t)ts * DM + it * 64 : nullptr;
  }
};
DI void phase_ffn1(const Params& p, int L, int* ctr, int* s_item, unsigned char* smem) {
  const bf16_t* Bt = p.wguT() + (size_t)L * 2 * DFF * DM;
  constexpr int LDG = 65;
  float* sg = (float*)smem;
  for (;;) {
    int mt, nt;
    if (!xcd_tile(ctr, s_item, 136, 44, mt, nt)) break;
    const int b = mt / 17, it_ = mt % 17;
    const int tbase = 254 * it_ - 2;
    f32x16 acc[4][2];
    AFfn1 af{p.xb() + (size_t)b * SEQ * DM, tbase};
    gemm_big(acc, af, Bt, DM, nt * 128, 16, smem, (PROBE_DRY && ctr >= p.ctr() + 512) ? PROBE_DM : 0);
    if (PROBE_DRY && ctr >= p.ctr() + 512) { if (acc[0][0][0] == 12345.678f) sg[0] = acc[1][1][3] + acc[2][0][5] + acc[3][1][7]; continue; }
    const int tid = tid_(), lane = tid & 63, w = tid >> 6, wm = w >> 1, wn = w & 1, r = lane & 31, lh = lane >> 5;
#pragma unroll
    for (int mi = 0; mi < 4; ++mi)
#pragma unroll
      for (int i = 0; i < 16; ++i) sg[(wm * 128 + mi * 32 + crow(i, lh)) * LDG + wn * 32 + r] = acc[mi][0][i];
    __syncthreads();
    const float* cw = p.convw + (size_t)L * 3 * DFF;
    const int fl = wn * 32 + r;
    const int f = nt * 64 + fl;
    const float w0 = cw[f], w1 = cw[DFF + f], w2 = cw[2 * DFF + f], cb = p.convb[(size_t)L * DFF + f];
#pragma unroll
    for (int mi = 0; mi < 4; ++mi) {
#pragma unroll
      for (int gq = 0; gq < 4; ++gq) {
        const int rbase = wm * 128 + mi * 32 + 8 * gq + 4 * lh;
        float prev1 = rbase >= 1 ? sg[(rbase - 1) * LDG + fl] : 0.f;
        float prev2 = rbase >= 2 ? sg[(rbase - 2) * LDG + fl] : 0.f;
#pragma unroll
        for (int k = 0; k < 4; ++k) {
          const int rr = rbase + k, ts = tbase + rr;
          const float gv = acc[mi][0][4 * gq + k];
          const float hc = cb + w0 * prev2 + w1 * prev1 + w2 * gv;
          if (rr >= 2 && ts < SEQ) p.act()[((size_t)b * SEQ + ts) * DFF + f] = f2bf(gelu_tanh(hc) * acc[mi][1][4 * gq + k]);
          prev2 = prev1; prev1 = gv;
        }
        __builtin_amdgcn_sched_barrier(0);
      }
    }
  }
}

DI void phase_ln(const Params& p, const float* lg, const float* lb, float2* stats, bool final_) {
  const int tid = tid_(), lane = tid & 63, w = tid >> 6;
  for (int row0 = (blockIdx.x * 4 + w) * 2; row0 < MTOK; row0 += gridDim.x * 8) {
    float4 v[2][4];
#pragma unroll
    for (int rr = 0; rr < 2; ++rr)
#pragma unroll
      for (int c = 0; c < 4; ++c) v[rr][c] = *(const float4*)(p.z + (size_t)(row0 + rr) * DM + c * 256 + lane * 4);
#pragma unroll
    for (int rr = 0; rr < 2; ++rr) {
      const int row = row0 + rr;
      float* zr = p.z + (size_t)row * DM;
      float s = 0.f;
#pragma unroll
      for (int c = 0; c < 4; ++c) s += v[rr][c].x + v[rr][c].y + v[rr][c].z + v[rr][c].w;
#pragma unroll
      for (int off = 32; off >= 1; off >>= 1) s += __shfl_xor(s, off);
      const float mu = s * (1.f / 1024.f);
      float q = 0.f;
#pragma unroll
      for (int c = 0; c < 4; ++c) {
        float a = v[rr][c].x - mu, b = v[rr][c].y - mu, cc = v[rr][c].z - mu, d = v[rr][c].w - mu;
        q += a * a + b * b + cc * cc + d * d;
      }
#pragma unroll
      for (int off = 32; off >= 1; off >>= 1) q += __shfl_xor(q, off);
      const float rstd = rsqrtf(q * (1.f / 1024.f) + 1e-5f);
      if (lane == 0) stats[row] = make_float2(mu, rstd);
#pragma unroll
      for (int c = 0; c < 4; ++c) {
        const int col = c * 256 + lane * 4;
        float4 gg = *(const float4*)(lg + col), bb = *(const float4*)(lb + col);
        float o0 = (v[rr][c].x - mu) * rstd * gg.x + bb.x, o1 = (v[rr][c].y - mu) * rstd * gg.y + bb.y;
        float o2 = (v[rr][c].z - mu) * rstd * gg.z + bb.z, o3 = (v[rr][c].w - mu) * rstd * gg.w + bb.w;
        if (final_) *(float4*)(zr + col) = make_float4(o0, o1, o2, o3);
        else { uint2 u; u.x = pack2(o0, o1); u.y = pack2(o2, o3); *(uint2*)(p.xb() + (size_t)row * DM + col) = u; }
      }
    }
  }
}

__global__ void __launch_bounds__(256, 2) mega(Params p_, int ph_lo, int ph_hi) {
  __shared__ __attribute__((aligned(16))) unsigned char smem[73728];
  __shared__ int s_item;
  int rep = 0; int first = 1; int nbar = 0;
  for (int ph = ph_lo; ph < ph_hi; ++ph) {
#if COOP
    if (!first) {
      ++nbar;
      if (ph_hi < 0) cg::this_grid().sync();
      grid_bar((unsigned*)(p_.ctr() + 2048), (unsigned)nbar);
    }
    first = 0;
#endif
    const Params& p = p_;
    int* ctr = p.ctr() + ph * 8;
    if (ph == 0) { phase_prep(p, smem); continue; }
    const int L = (ph - 1) / 9, sub = (ph - 1) % 9;
#ifdef PROBE_MASK
    if (((PROBE_MASK >> sub) & 1) && !((sub == 4 || sub == 8) && L != 0) && sub != 7) {
      if (rep == 0) { --ph; rep = 1; ctr += 512; } else { rep = 0; }
    }
#endif
    switch (sub) {
      case 0: phase_inproj(p, L, ctr, &s_item, smem); break;
      case 1: phase_mixA(p, L, ctr, &s_item, smem); break;
      case 2: phase_mixB(p, L, ctr, &s_item, smem); break;
      case 3: phase_mixC(p, L, ctr, &s_item, smem); break;
      case 4: phase_outproj(p, L, ctr, &s_item, smem); break;
      case 5: phase_ln(p, p.ln1g + (size_t)L * DM, p.ln1b + (size_t)L * DM, p.stats1(), false); break;
      case 6: phase_ffn1(p, L, ctr, &s_item, smem); break;
      case 7: phase_ffn2(p, L, ctr, &s_item, smem); break;
      default: phase_ln(p, p.ln2g + (size_t)L * DM, p.ln2b + (size_t)L * DM, p.stats2(), L == 1); break;
    }
  }
}

extern "C" void kernel_launch(void* const* d_in, const int* in_sizes, int n_in, void* d_out, int out_size, void* d_ws, size_t ws_size,
                              hipStream_t stream) {
  Params p{};
  p.x = (const float*)d_in[0]; p.pos = (const int*)d_in[1]; p.w_in = (const float*)d_in[2]; p.w_out = (const float*)d_in[3];
  p.pool_w = (const float*)d_in[4]; p.pool_scale = (const float*)d_in[5]; p.gn_g = (const float*)d_in[6];
  p.cpos_k = (const float*)d_in[7]; p.cw1_k = (const float*)d_in[8]; p.cb1_k = (const float*)d_in[9]; p.cw2_k = (const float*)d_in[10];
  p.cpos_v = (const float*)d_in[11]; p.cw1_v = (const float*)d_in[12]; p.cb1_v = (const float*)d_in[13]; p.cw2_v = (const float*)d_in[14];
  p.wg = (const float*)d_in[15]; p.wu = (const float*)d_in[16]; p.convw = (const float*)d_in[17]; p.convb = (const float*)d_in[18];
  p.wd = (const float*)d_in[19]; p.ln1g = (const float*)d_in[20]; p.ln1b = (const float*)d_in[21]; p.ln2g = (const float*)d_in[22];
  p.ln2b = (const float*)d_in[23];
  p.z = (float*)d_out;
  p.ws = (unsigned char*)d_ws;
  if (WS_NEED > ws_size) { fprintf(stderr, "workspace too small: need %zu have %zu\n", (size_t)WS_NEED, ws_size); return; }

  (void)hipMemsetAsync(d_ws, 0, 16384, stream);
#if COOP
  static int grid_blocks = 0;
  if (!grid_blocks) {
    int dev = 0, cus = 0, per_cu = 0;
    hipGetDevice(&dev);
    hipDeviceGetAttribute(&cus, hipDeviceAttributeMultiprocessorCount, dev);
    hipOccupancyMaxActiveBlocksPerMultiprocessor(&per_cu, mega, 256, 0);
    if (per_cu > 2) per_cu = 2;
    grid_blocks = cus * per_cu;
  }
  int lo = 0, hi = NPHASE;
  void* args[] = {&p, &lo, &hi};
  hipError_t e = hipLaunchCooperativeKernel((void*)mega, dim3(grid_blocks), dim3(256), args, 0, stream);
  if (e != hipSuccess) fprintf(stderr, "cooperative launch failed: %s (grid %d)\n", hipGetErrorString(e), grid_blocks);
#else
  for (int ph = 0; ph < NPHASE; ++ph) mega<<<512, 256, 0, stream>>>(p, ph, ph + 1);
#endif
}
```

```cpp
#include <hip/hip_runtime.h>
#include <hip/hip_cooperative_groups.h>
#include <stdint.h>
#include <stdio.h>
namespace cg = cooperative_groups;

typedef unsigned short bf16_t;
typedef __attribute__((ext_vector_type(8))) short bf16x8;
typedef __attribute__((ext_vector_type(4))) short bf16x4;
typedef __attribute__((ext_vector_type(16))) float f32x16;
typedef __attribute__((ext_vector_type(2))) __bf16 bfv2;
typedef __attribute__((ext_vector_type(2))) float fv2;
typedef unsigned long long u64;
#define DI __device__ __forceinline__
#define MFMA32(a, b, c) __builtin_amdgcn_mfma_f32_32x32x16_bf16((a), (b), (c), 0, 0, 0)

#ifndef COOP
#define COOP 1
#ifndef PROBE_DRY
#define PROBE_DRY 0
#endif
#ifndef PROBE_DM
#define PROBE_DM 0
#endif
#endif

constexpr int MTOK = 32768, SEQ = 4096, DM = 1024, NIN = 2962, NINP = 3072, DFF = 2816;
constexpr float LOG2E = 1.4426950408889634f;
constexpr float ALPHA = 1.4142135623730951f;
constexpr int NPHASE = 19;

constexpr size_t al256(size_t v) { return (v + 255) & ~(size_t)255; }
constexpr size_t M_ = MTOK;
constexpr size_t OFF_ctr = 0;
constexpr size_t OFF_stats1 = OFF_ctr + al256(16384);
constexpr size_t OFF_stats2 = OFF_stats1 + al256(M_*8);
constexpr size_t OFF_tab = OFF_stats2 + al256(M_*8);
constexpr size_t OFF_c1 = OFF_tab + al256(M_*32*8);
constexpr size_t OFF_winT = OFF_c1 + al256(4*64*128*4);
constexpr size_t OFF_woutT = OFF_winT + al256((size_t)2*NINP*DM*2);
constexpr size_t OFF_wguT = OFF_woutT + al256((size_t)2*DM*DM*2);
constexpr size_t OFF_wdT = OFF_wguT + al256((size_t)2*2*DFF*DM*2);
constexpr size_t OFF_w1T = OFF_wdT + al256((size_t)2*DM*DFF*2);
constexpr size_t OFF_w2T = OFF_w1T + al256((size_t)4*128*2048*2);
constexpr size_t OFF_pwT = OFF_w2T + al256((size_t)4*64*128*2);
constexpr size_t OFF_xb = OFF_pwT + al256((size_t)8*64*64*2);
constexpr size_t OFF_y = OFF_xb + al256(M_*DM*2);
constexpr size_t OFF_ocmp = OFF_y + al256(M_*DM*2);
constexpr size_t OFF_owin = OFF_ocmp + al256(M_*384*2);
constexpr size_t OFF_gates = OFF_owin + al256(M_*384*2);
constexpr size_t OFF_kvT = OFF_gates + al256(M_*18*4);
constexpr size_t OFF_RT = OFF_kvT + al256((size_t)48*32*4096*4);
constexpr size_t OFF_kc = OFF_RT + al256((size_t)48*32*4096*2);
constexpr size_t OFF_vcT = OFF_kc + al256((size_t)16*256*64*2);
constexpr size_t OFF_sel = OFF_vcT + al256((size_t)16*64*256*2);
constexpr size_t OFF_vpool = OFF_sel + al256((size_t)16*SEQ*8);
constexpr size_t OFF_qret = OFF_vpool + al256(M_*256*2);
constexpr size_t OFF_kret = OFF_qret + al256(M_*384*2);
constexpr size_t OFF_kzT = OFF_kret + al256(M_*384*2);
constexpr size_t OFF_vrT = OFF_kzT + al256(M_*384*2);
constexpr size_t OFF_gret = OFF_vrT + al256(M_*384*2);
constexpr size_t OFF_qnsa = OFF_gret + al256(M_*384*2);
constexpr size_t OFF_kcmp = OFF_qnsa + al256(M_*384*2);
constexpr size_t OFF_vcmp = OFF_kcmp + al256(M_*128*2);
constexpr size_t OFF_kslc = OFF_vcmp + al256(M_*128*2);
constexpr size_t OFF_vslT = OFF_kslc + al256(M_*128*2);
constexpr size_t OFF_kwin = OFF_vslT + al256(M_*128*2);
constexpr size_t OFF_vwT = OFF_kwin + al256(M_*128*2);
constexpr size_t WS_NEED = OFF_vwT + al256(M_*128*2);
constexpr size_t OFF_act = OFF_vpool;
struct Params {
  const float* x; const int* pos; const float* w_in; const float* w_out; const float* pool_w; const float* pool_scale;
  const float* gn_g; const float* cpos_k; const float* cw1_k; const float* cb1_k; const float* cw2_k;
  const float* cpos_v; const float* cw1_v; const float* cb1_v; const float* cw2_v;
  const float* wg; const float* wu; const float* convw; const float* convb; const float* wd;
  const float* ln1g; const float* ln1b; const float* ln2g; const float* ln2b;
  float* z;
  unsigned char* ws;
  DI int* ctr() const { return (int*)(ws + OFF_ctr); }
  DI float2* stats1() const { return (float2*)(ws + OFF_stats1); }
  DI float2* stats2() const { return (float2*)(ws + OFF_stats2); }
  DI float2* tab() const { return (float2*)(ws + OFF_tab); }
  DI float* c1() const { return (float*)(ws + OFF_c1); }
  DI bf16_t* winT() const { return (bf16_t*)(ws + OFF_winT); }
  DI bf16_t* woutT() const { return (bf16_t*)(ws + OFF_woutT); }
  DI bf16_t* wguT() const { return (bf16_t*)(ws + OFF_wguT); }
  DI bf16_t* wdT() const { return (bf16_t*)(ws + OFF_wdT); }
  DI bf16_t* w1T() const { return (bf16_t*)(ws + OFF_w1T); }
  DI bf16_t* w2T() const { return (bf16_t*)(ws + OFF_w2T); }
  DI bf16_t* pwT() const { return (bf16_t*)(ws + OFF_pwT); }
  DI bf16_t* xb() const { return (bf16_t*)(ws + OFF_xb); }
  DI bf16_t* y() const { return (bf16_t*)(ws + OFF_y); }
  DI bf16_t* ocmp() const { return (bf16_t*)(ws + OFF_ocmp); }
  DI bf16_t* owin() const { return (bf16_t*)(ws + OFF_owin); }
  DI float* gates() const { return (float*)(ws + OFF_gates); }
  DI float* kvT() const { return (float*)(ws + OFF_kvT); }
  DI bf16_t* RT() const { return (bf16_t*)(ws + OFF_RT); }
  DI bf16_t* kc() const { return (bf16_t*)(ws + OFF_kc); }
  DI bf16_t* vcT() const { return (bf16_t*)(ws + OFF_vcT); }
  DI u64* sel() const { return (u64*)(ws + OFF_sel); }
  DI bf16_t* vpool() const { return (bf16_t*)(ws + OFF_vpool); }
  DI bf16_t* qret() const { return (bf16_t*)(ws + OFF_qret); }
  DI bf16_t* kret() const { return (bf16_t*)(ws + OFF_kret); }
  DI bf16_t* kzT() const { return (bf16_t*)(ws + OFF_kzT); }
  DI bf16_t* vrT() const { return (bf16_t*)(ws + OFF_vrT); }
  DI bf16_t* gret() const { return (bf16_t*)(ws + OFF_gret); }
  DI bf16_t* qnsa() const { return (bf16_t*)(ws + OFF_qnsa); }
  DI bf16_t* kcmp() const { return (bf16_t*)(ws + OFF_kcmp); }
  DI bf16_t* vcmp() const { return (bf16_t*)(ws + OFF_vcmp); }
  DI bf16_t* kslc() const { return (bf16_t*)(ws + OFF_kslc); }
  DI bf16_t* vslT() const { return (bf16_t*)(ws + OFF_vslT); }
  DI bf16_t* kwin() const { return (bf16_t*)(ws + OFF_kwin); }
  DI bf16_t* vwT() const { return (bf16_t*)(ws + OFF_vwT); }
  DI bf16_t* act() const { return (bf16_t*)(ws + OFF_act); }
};

DI int tid_() { int t = __builtin_amdgcn_workitem_id_x(); asm volatile("" : "+v"(t)); return t; }
DI unsigned pack2(float a, float b) { fv2 v = {a, b}; bfv2 r = __builtin_convertvector(v, bfv2); return __builtin_bit_cast(unsigned, r); }
DI bf16_t f2bf(float a) { return (bf16_t)(pack2(a, 0.f) & 0xffffu); }
DI float bf2f(bf16_t v) { return __uint_as_float(((unsigned)v) << 16); }
DI int crow(int i, int lh) { return (i & 3) + 8 * (i >> 2) + 4 * lh; }
DI float gelu_tanh(float x) {
  float u = 0.7978845608028654f * (x + 0.044715f * x * x * x);
  float e = __expf(2.f * u);
  float th = 1.f - 2.f / (e + 1.f);
  return 0.5f * x * (1.f + th);
}
DI float sigmoidf_(float x) { return 1.f / (1.f + __expf(-x)); }
DI float xor32(float v) { return __shfl_xor(v, 32); }

DI int next_item(int* ctr, int* s_item) {
  __syncthreads();
  if (tid_() == 0) *s_item = atomicAdd(ctr, 1);
  __syncthreads();
  return *s_item;
}


DI void grid_bar(unsigned* bw, unsigned k) {
  asm volatile("s_waitcnt vmcnt(0)" ::: "memory");
  __syncthreads();
  if (tid_() == 0) {
    __builtin_amdgcn_fence(__ATOMIC_RELEASE, "agent");
    asm volatile("s_waitcnt vmcnt(0)" ::: "memory");
    const unsigned g = blockIdx.x & 7u, nloc = (gridDim.x - g + 7u) >> 3;
    const unsigned old = __hip_atomic_fetch_add(&bw[64 * g], 1u, __ATOMIC_RELAXED, __HIP_MEMORY_SCOPE_AGENT);
    if (old + 1u == k * nloc) {
      const unsigned ot = __hip_atomic_fetch_add(&bw[64 * 8], 1u, __ATOMIC_RELAXED, __HIP_MEMORY_SCOPE_AGENT);
      if (ot + 1u == k * 8u) __hip_atomic_fetch_add(&bw[64 * 9], 1u, __ATOMIC_RELAXED, __HIP_MEMORY_SCOPE_AGENT);
    }
    while (__hip_atomic_load(&bw[64 * 9], __ATOMIC_RELAXED, __HIP_MEMORY_SCOPE_AGENT) < k) __builtin_amdgcn_s_sleep(1);
    __builtin_amdgcn_fence(__ATOMIC_ACQUIRE, "agent");
    asm volatile("s_waitcnt vmcnt(0)" ::: "memory");
  }
  __syncthreads();
}

DI bool xcd_tile(int* ctr, int* s_item, int mtiles, int ntiles, int& mt, int& nt) {
  const int x = blockIdx.x & 7;
  const int q = next_item(ctr + x, s_item);
  const int per = mtiles >> 3;
  if (q >= per * ntiles) return false;
  const int fg = per >> 2, rem = per & 3;
  int ml;
  if (q < fg * 4 * ntiles) { const int g = q / (4 * ntiles), wq = q % (4 * ntiles); nt = wq >> 2; ml = 4 * g + (wq & 3); }
  else { const int q2 = q - fg * 4 * ntiles; nt = q2 / rem; ml = 4 * fg + q2 % rem; }
  mt = x * per + ml;
  return true;
}

constexpr int LDT = 72;
template <class AF>
DI void gemm_main(f32x16 (&acc)[2][2], AF af, const bf16_t* __restrict__ Bt, int ldb, int n0, int kiters, unsigned char* smem) {
  bf16_t* sA = (bf16_t*)smem;
  bf16_t* sB = (bf16_t*)(smem + 2 * 128 * LDT * 2);
  const int tid = tid_(), lane = tid & 63, w = tid >> 6, wm = w >> 1, wn = w & 1;
  const int r = lane & 31, lh = lane >> 5;
  const int lrow = tid >> 3, lch = tid & 7;
#pragma unroll
  for (int a = 0; a < 2; ++a)
#pragma unroll
    for (int b = 0; b < 2; ++b)
#pragma unroll
      for (int i = 0; i < 16; ++i) acc[a][b][i] = 0.f;
  uint4 ra[4], rb[4];
  const bf16_t* bptr = Bt + (size_t)(n0 + lrow) * ldb + lch * 8;
#define GLOAD(it)                                                                  \
  {                                                                                \
    _Pragma("unroll") for (int c = 0; c < 4; ++c) {                                \
      const bf16_t* pa = af(lrow + 32 * c, (it));                                  \
      ra[c] = pa ? *(const uint4*)(pa + lch * 8) : make_uint4(0, 0, 0, 0);         \
      rb[c] = *(const uint4*)(bptr + (size_t)(32 * c) * ldb + (it) * 64);          \
    }                                                                              \
  }
#define SSTORE(buf)                                                                \
  {                                                                                \
    _Pragma("unroll") for (int c = 0; c < 4; ++c) {                                \
      *(uint4*)(sA + (buf) * 128 * LDT + (lrow + 32 * c) * LDT + lch * 8) = ra[c]; \
      *(uint4*)(sB + (buf) * 128 * LDT + (lrow + 32 * c) * LDT + lch * 8) = rb[c]; \
    }                                                                              \
  }
  GLOAD(0);
  SSTORE(0);
  __syncthreads();
  for (int it = 0; it < kiters; ++it) {
    const int cur = it & 1;
    if (it + 1 < kiters) GLOAD(it + 1);
    const bf16_t* a_base = sA + cur * 128 * LDT + (wm * 64 + r) * LDT + 8 * lh;
    const bf16_t* b_base = sB + cur * 128 * LDT + (wn * 64 + r) * LDT + 8 * lh;
#pragma unroll
    for (int s = 0; s < 4; ++s) {
      bf16x8 a0 = *(const bf16x8*)(a_base + s * 16);
      bf16x8 a1 = *(const bf16x8*)(a_base + 32 * LDT + s * 16);
      bf16x8 b0 = *(const bf16x8*)(b_base + s * 16);
      bf16x8 b1 = *(const bf16x8*)(b_base + 32 * LDT + s * 16);
      acc[0][0] = MFMA32(a0, b0, acc[0][0]);
      acc[0][1] = MFMA32(a0, b1, acc[0][1]);
      acc[1][0] = MFMA32(a1, b0, acc[1][0]);
      acc[1][1] = MFMA32(a1, b1, acc[1][1]);
    }
    if (it + 1 < kiters) SSTORE(cur ^ 1);
    __syncthreads();
  }
#undef GLOAD
#undef SSTORE
}

template <class AF>
DI void gemm_big(f32x16 (&acc)[4][2], AF af, const bf16_t* __restrict__ Bt, int ldb, int n0, int kiters, unsigned char* smem, int dm = 0) {
  bf16_t* sA = (bf16_t*)smem;
  bf16_t* sB = (bf16_t*)(smem + 256 * LDT * 2);
  const int tid = tid_(), lane = tid & 63, w = tid >> 6, wm = w >> 1, wn = w & 1;
  const int r = lane & 31, lh = lane >> 5;
  const int lrow = tid >> 3, lch = tid & 7;
#pragma unroll
  for (int a = 0; a < 4; ++a)
#pragma unroll
    for (int b = 0; b < 2; ++b)
#pragma unroll
      for (int i = 0; i < 16; ++i) acc[a][b][i] = 0.f;
  uint4 ra0, ra1, ra2, ra3, ra4, ra5, ra6, ra7, rb0, rb1, rb2, rb3;
  const bf16_t* bptr = Bt + (size_t)(n0 + lrow) * ldb + lch * 8;
  const size_t bstep = (size_t)32 * ldb;
#define GLA(ra, c, it)                                                            \
  {                                                                               \
    const bf16_t* pa = af(lrow + 32 * (c), (it));                                 \
    ra = pa ? *(const uint4*)(pa + lch * 8) : make_uint4(0, 0, 0, 0);             \
  }
#define GLB(rb, c, it) { rb = *(const uint4*)(bptr + bstep * (c) + (it) * 64); }
#define GLOAD0(it)                                                                \
  {                                                                               \
    GLA(ra0, 0, it) GLA(ra1, 1, it) GLA(ra2, 2, it) GLA(ra3, 3, it)               \
    GLA(ra4, 4, it) GLA(ra5, 5, it) GLA(ra6, 6, it) GLA(ra7, 7, it)               \
    GLB(rb0, 0, it) GLB(rb1, 1, it) GLB(rb2, 2, it) GLB(rb3, 3, it)               \
  }
#define GLOAD1(it)                                                                \
  {                                                                               \
    GLA(qa0, 0, it) GLA(qa1, 1, it) GLA(qa2, 2, it) GLA(qa3, 3, it)               \
    GLA(qa4, 4, it) GLA(qa5, 5, it) GLA(qa6, 6, it) GLA(qa7, 7, it)               \
    GLB(qb0, 0, it) GLB(qb1, 1, it) GLB(qb2, 2, it) GLB(qb3, 3, it)               \
  }
#define SSA(ra, c, buf) { *(uint4*)(sA + (buf) * 256 * LDT + (lrow + 32 * (c)) * LDT + lch * 8) = ra; }
#define SSB(rb, c, buf) { *(uint4*)(sB + (buf) * 128 * LDT + (lrow + 32 * (c)) * LDT + lch * 8) = rb; }
#define SSTORE0(buf)                                                              \
  {                                                                               \
    SSA(ra0, 0, buf) SSA(ra1, 1, buf) SSA(ra2, 2, buf) SSA(ra3, 3, buf)           \
    SSA(ra4, 4, buf) SSA(ra5, 5, buf) SSA(ra6, 6, buf) SSA(ra7, 7, buf)           \
    SSB(rb0, 0, buf) SSB(rb1, 1, buf) SSB(rb2, 2, buf) SSB(rb3, 3, buf)           \
  }
#define SSTORE1(buf)                                                              \
  {                                                                               \
    SSA(qa0, 0, buf) SSA(qa1, 1, buf) SSA(qa2, 2, buf) SSA(qa3, 3, buf)           \
    SSA(qa4, 4, buf) SSA(qa5, 5, buf) SSA(qa6, 6, buf) SSA(qa7, 7, buf)           \
    SSB(qb0, 0, buf) SSB(qb1, 1, buf) SSB(qb2, 2, buf) SSB(qb3, 3, buf)           \
  }
#define COMPUTE(buf, LP0, LP1, LP2, LP3)                                                                     \
  {                                                                                                          \
    const bf16_t* a_base = sA + (buf) * 256 * LDT + (wm * 128 + r) * LDT + 8 * lh;                           \
    const bf16_t* b_base = sB + (buf) * 128 * LDT + (wn * 64 + r) * LDT + 8 * lh;                            \
    __builtin_amdgcn_s_setprio(1);                                                                           \
    _Pragma("unroll") for (int s = 0; s < 4; ++s) {                                                          \
      bf16x8 fa[4], fb[2];                                                                                   \
      _Pragma("unroll") for (int q = 0; q < 4; ++q) fa[q] = *(const bf16x8*)(a_base + q * 32 * LDT + s * 16); \
      _Pragma("unroll") for (int q = 0; q < 2; ++q) fb[q] = *(const bf16x8*)(b_base + q * 32 * LDT + s * 16); \
      if (s == 0) { LP0 } else if (s == 1) { LP1 } else if (s == 2) { LP2 } else { LP3 }                     \
      _Pragma("unroll") for (int mi = 0; mi < 4; ++mi)                                                       \
          _Pragma("unroll") for (int ni = 0; ni < 2; ++ni)                                                   \
              acc[mi][ni] = MFMA32(fa[mi], fb[ni], acc[mi][ni]);                                             \
      __builtin_amdgcn_sched_barrier(0);                                                                     \
    }                                                                                                        \
    __builtin_amdgcn_s_setprio(0);                                                                           \
  }
  GLOAD0(0);
  SSTORE0(0);
  __syncthreads();
  const int klast = kiters - 1;
#pragma unroll 1
  for (int it = 0; it < kiters; ++it) {
    const int i1 = (it + 1 < kiters) ? it + 1 : klast;
    COMPUTE(0, GLA(ra0, 0, i1) GLA(ra1, 1, i1) GLA(ra2, 2, i1), GLA(ra3, 3, i1) GLA(ra4, 4, i1) GLA(ra5, 5, i1),
            GLA(ra6, 6, i1) GLA(ra7, 7, i1) GLB(rb0, 0, i1), GLB(rb1, 1, i1) GLB(rb2, 2, i1) GLB(rb3, 3, i1));
    __syncthreads();
    SSTORE0(0);
    __syncthreads();
  }
#undef GLA
#undef GLB
#undef GLOAD0
#undef GLOAD1
#undef SSA
#undef SSB
#undef SSTORE0
#undef SSTORE1
#undef COMPUTE
}

struct ARowMajor {
  const bf16_t* A; int lda; int m0;
  DI const bf16_t* operator()(int row, int it) const { return A + (size_t)(m0 + row) * lda + it * 64; }
};

DI void store_rm(const f32x16 (&v)[2][2], bf16_t* dst, int ld, int row0, int col0, int r, int lh) {
#pragma unroll
  for (int mi = 0; mi < 2; ++mi)
#pragma unroll
    for (int ni = 0; ni < 2; ++ni)
#pragma unroll
      for (int i = 0; i < 16; ++i) dst[(size_t)(row0 + mi * 32 + crow(i, lh)) * ld + col0 + ni * 32 + r] = f2bf(v[mi][ni][i]);
}
DI void store_T(const f32x16 (&v)[2][2], bf16_t* dstT, int t0, int r, int lh) {
#pragma unroll
  for (int mi = 0; mi < 2; ++mi)
#pragma unroll
    for (int ni = 0; ni < 2; ++ni)
#pragma unroll
      for (int g = 0; g < 4; ++g) {
        uint2 u;
        u.x = pack2(v[mi][ni][4 * g], v[mi][ni][4 * g + 1]);
        u.y = pack2(v[mi][ni][4 * g + 2], v[mi][ni][4 * g + 3]);
        *(uint2*)(dstT + (size_t)(ni * 32 + r) * SEQ + t0 + mi * 32 + 8 * g + 4 * lh) = u;
      }
}
DI void rope_tile(f32x16 (&v)[2][2], const float2* tab, int row0, int r, int lh, float scale) {
#pragma unroll
  for (int mi = 0; mi < 2; ++mi)
#pragma unroll
    for (int i = 0; i < 16; ++i) {
      float2 cs = tab[(size_t)(row0 + mi * 32 + crow(i, lh)) * 32 + r];
      float x1 = v[mi][0][i], x2 = v[mi][1][i];
      v[mi][0][i] = (x1 * cs.x - x2 * cs.y) * scale;
      v[mi][1][i] = (x2 * cs.x + x1 * cs.y) * scale;
    }
}

constexpr int LDS_RM = 72;
constexpr int LDS_T = 136;
DI void stage_rm(const f32x16 (&v)[4][2], bf16_t* st, int r, int lh) {
#pragma unroll
  for (int mi = 0; mi < 4; ++mi)
#pragma unroll
    for (int ni = 0; ni < 2; ++ni)
#pragma unroll
      for (int i = 0; i < 16; ++i) st[(mi * 32 + crow(i, lh)) * LDS_RM + ni * 32 + r] = f2bf(v[mi][ni][i]);
}
DI void flush_rm(const bf16_t* st, bf16_t* dst, int ld, int lane) {
  const int rr = lane >> 3, ch = lane & 7;
#pragma unroll 4
  for (int k = 0; k < 16; ++k) {
    const int row = k * 8 + rr;
    *(uint4*)(dst + (size_t)row * ld + ch * 8) = *(const uint4*)(st + row * LDS_RM + ch * 8);
  }
}
DI void stage_T(const f32x16 (&v)[4][2], bf16_t* st, int r, int lh) {
#pragma unroll
  for (int mi = 0; mi < 4; ++mi)
#pragma unroll
    for (int ni = 0; ni < 2; ++ni)
#pragma unroll
      for (int g = 0; g < 4; ++g) {
        uint2 u;
        u.x = pack2(v[mi][ni][4 * g], v[mi][ni][4 * g + 1]);
        u.y = pack2(v[mi][ni][4 * g + 2], v[mi][ni][4 * g + 3]);
        *(uint2*)(st + (ni * 32 + r) * LDS_T + mi * 32 + 8 * g + 4 * lh) = u;
      }
}
DI void flush_T(const bf16_t* st, bf16_t* dstT, int lane) {
  const int dd = lane >> 4, ch = lane & 15;
#pragma unroll 4
  for (int k = 0; k < 16; ++k) {
    const int d = k * 4 + dd;
    *(uint4*)(dstT + (size_t)d * SEQ + ch * 8) = *(const uint4*)(st + d * LDS_T + ch * 8);
  }
}
DI void rope_tile4(f32x16 (&v)[4][2], const float2* tab, int row0, int r, int lh, float scale) {
#pragma unroll
  for (int mi = 0; mi < 4; ++mi) {
#pragma unroll
    for (int i = 0; i < 16; ++i) {
      float2 cs = tab[(size_t)(row0 + mi * 32 + crow(i, lh)) * 32 + r];
      float x1 = v[mi][0][i], x2 = v[mi][1][i];
      v[mi][0][i] = (x1 * cs.x - x2 * cs.y) * scale;
      v[mi][1][i] = (x2 * cs.x + x1 * cs.y) * scale;
    }
    __builtin_amdgcn_sched_barrier(0);
  }
}
DI float ret_l2g(int hd) { return log2f(1.f - exp2f(-(float)(5 + hd))); }

DI void conv_tile(const float* src, int N, bf16_t* dst, int ldd, int k0, int n0, int mode, float* st) {
  const int tid = tid_();
#pragma unroll
  for (int c = 0; c < 8; ++c) {
    const int idx = tid + 256 * c, kk = idx >> 5, n2 = idx & 31, n = n0 + 2 * n2;
    float2 v = make_float2(0.f, 0.f);
    if (n < N) v = *(const float2*)(src + (size_t)(k0 + kk) * N + n);
    st[kk * 65 + 2 * n2] = v.x;
    st[kk * 65 + 2 * n2 + 1] = v.y;
  }
  __syncthreads();
#pragma unroll
  for (int c = 0; c < 4; ++c) {
    const int idx = tid + 256 * c, nn = idx >> 4, k4 = idx & 15, n = n0 + nn;
    const int drow = (mode == 0) ? n : (64 * (n >> 5) + (mode == 2 ? 32 : 0) + (n & 31));
    uint2 u;
    u.x = pack2(st[(4 * k4) * 65 + nn], st[(4 * k4 + 1) * 65 + nn]);
    u.y = pack2(st[(4 * k4 + 2) * 65 + nn], st[(4 * k4 + 3) * 65 + nn]);
    *(uint2*)(dst + (size_t)drow * ldd + k0 + 4 * k4) = u;
  }
  __syncthreads();
}

DI void phase_prep(const Params& p, unsigned char* smem) {
  float* st = (float*)smem;
  const int tid = tid_();
  constexpr int PER = 3268;
  for (int idx = blockIdx.x; idx < 2 * PER; idx += gridDim.x) {
    int L = idx / PER, j = idx % PER;
    if (j < 768) { conv_tile(p.w_in + (size_t)L * DM * NIN, NIN, p.winT() + (size_t)L * NINP * DM, DM, (j / 48) * 64, (j % 48) * 64, 0, st); continue; }
    j -= 768;
    if (j < 256) { conv_tile(p.w_out + (size_t)L * DM * DM, DM, p.woutT() + (size_t)L * DM * DM, DM, (j / 16) * 64, (j % 16) * 64, 0, st); continue; }
    j -= 256;
    if (j < 704) { conv_tile(p.wg + (size_t)L * DM * DFF, DFF, p.wguT() + (size_t)L * 2 * DFF * DM, DM, (j / 44) * 64, (j % 44) * 64, 1, st); continue; }
    j -= 704;
    if (j < 704) { conv_tile(p.wu + (size_t)L * DM * DFF, DFF, p.wguT() + (size_t)L * 2 * DFF * DM, DM, (j / 44) * 64, (j % 44) * 64, 2, st); continue; }
    j -= 704;
    if (j < 704) { conv_tile(p.wd + (size_t)L * DFF * DM, DM, p.wdT() + (size_t)L * DM * DFF, DFF, (j / 16) * 64, (j % 16) * 64, 0, st); continue; }
    j -= 704;
    if (j < 64) { conv_tile(p.cw1_k + (size_t)L * 2048 * 128, 128, p.w1T() + (size_t)(L * 2 + 0) * 128 * 2048, 2048, (j / 2) * 64, (j % 2) * 64, 0, st); continue; }
    j -= 64;
    if (j < 64) { conv_tile(p.cw1_v + (size_t)L * 2048 * 128, 128, p.w1T() + (size_t)(L * 2 + 1) * 128 * 2048, 2048, (j / 2) * 64, (j % 2) * 64, 0, st); continue; }
    j -= 64;
    if (j < 2) { conv_tile(p.cw2_k + (size_t)L * 128 * 64, 64, p.w2T() + (size_t)(L * 2 + 0) * 64 * 128, 128, j * 64, 0, 0, st); continue; }
    j -= 2;
    conv_tile(p.cw2_v + (size_t)L * 128 * 64, 64, p.w2T() + (size_t)(L * 2 + 1) * 64 * 128, 128, j * 64, 0, 0, st);
  }
  for (int idx = blockIdx.x; idx < 8; idx += gridDim.x)
    conv_tile(p.pool_w + (size_t)idx * 4096, 64, p.pwT() + (size_t)idx * 4096, 64, 0, 0, 0, st);
  const size_t gtid = (size_t)blockIdx.x * 256 + tid, gstride = (size_t)gridDim.x * 256;
  for (size_t i = gtid; i < (size_t)MTOK * DM / 4; i += gstride) {
    float4 v = ((const float4*)p.x)[i];
    uint2 u; u.x = pack2(v.x, v.y); u.y = pack2(v.z, v.w);
    ((uint2*)p.xb())[i] = u;
  }
  for (size_t i = gtid; i < (size_t)MTOK * 32; i += gstride) {
    int tok = (int)(i >> 5), k = (int)(i & 31);
    float inv = exp2f(-(float)k * 0.41524101186092029f);
    float ang = (float)p.pos[tok] * inv;
    float kk = rintf(ang * 0.15915494309189535f);
    float rr = fmaf(-kk, 6.2831854820251465f, ang);
    rr = fmaf(-kk, -1.7484556000744883e-07f, rr);
    p.tab()[i] = make_float2(__cosf(rr), __sinf(rr));
  }
  for (int blk = blockIdx.x; blk < 256; blk += gridDim.x) {
    if (tid < 128) {
      const int lw = blk >> 6, kb = blk & 63, L = lw >> 1, which = lw & 1;
      const float* pe = (which ? p.cpos_v : p.cpos_k) + (size_t)L * 2048 + kb * 32;
      const float* w1 = (which ? p.cw1_v : p.cw1_k) + (size_t)L * 2048 * 128 + (size_t)kb * 32 * 128;
      float s = 0.f;
#pragma unroll 8
      for (int k = 0; k < 32; ++k) s = fmaf(pe[k], w1[(size_t)k * 128 + tid], s);
      p.c1()[(size_t)(lw * 64 + kb) * 128 + tid] = s;
    }
  }
}

DI void epi_inproj(f32x16 (&acc)[4][2], int m0, int n0, const Params& p, unsigned char* smem) {
  const int tid = tid_(), lane = tid & 63, w = tid >> 6, wm = w >> 1, wn = w & 1, r = lane & 31, lh = lane >> 5;
  const int cw = n0 + wn * 64;
  const int row0 = m0 + wm * 128;
  const int b = row0 >> 12, t0 = row0 & 4095;
  bf16_t* st = (bf16_t*)(smem + w * 18432);
  bf16_t* rm_dst = nullptr; int rm_ld = 0; bf16_t* t_dst = nullptr; int mode = 0;
  if (cw < 256) { rm_dst = p.vpool() + (size_t)row0 * 256 + cw; rm_ld = 256; }
  else if (cw < 640) { rm_dst = p.qret() + (size_t)row0 * 384 + (cw - 256); rm_ld = 384; mode = 1; }
  else if (cw < 1024) { rm_dst = p.kret() + (size_t)row0 * 384 + (cw - 640); rm_ld = 384; mode = 4; t_dst = p.kzT() + (size_t)((b * 6 + ((cw - 640) >> 6)) * 64) * SEQ + t0; }
  else if (cw < 1408) { t_dst = p.vrT() + (size_t)((b * 6 + ((cw - 1024) >> 6)) * 64) * SEQ + t0; }
  else if (cw < 1792) { rm_dst = p.gret() + (size_t)row0 * 384 + (cw - 1408); rm_ld = 384; mode = 3; }
  else if (cw < 2176) { rm_dst = p.qnsa() + (size_t)row0 * 384 + (cw - 1792); rm_ld = 384; mode = 2; }
  else if (cw < 2304) { rm_dst = p.kcmp() + (size_t)row0 * 128 + (cw - 2176); rm_ld = 128; }
  else if (cw < 2432) { rm_dst = p.vcmp() + (size_t)row0 * 128 + (cw - 2304); rm_ld = 128; }
  else if (cw < 2560) { rm_dst = p.kslc() + (size_t)row0 * 128 + (cw - 2432); rm_ld = 128; mode = 1; }
  else if (cw < 2688) { t_dst = p.vslT() + (size_t)((b * 2 + ((cw - 2560) >> 6)) * 64) * SEQ + t0; }
  else if (cw < 2816) { rm_dst = p.kwin() + (size_t)row0 * 128 + (cw - 2688); rm_ld = 128; mode = 1; }
  else if (cw < 2944) { t_dst = p.vwT() + (size_t)((b * 2 + ((cw - 2816) >> 6)) * 64) * SEQ + t0; }
  else if (cw == 2944) {
    if (r < 18) {
#pragma unroll
      for (int mi = 0; mi < 4; ++mi)
#pragma unroll
        for (int i = 0; i < 16; ++i) p.gates()[(size_t)(row0 + mi * 32 + crow(i, lh)) * 18 + r] = sigmoidf_(acc[mi][0][i]);
    }
  }
  if (mode == 1 || mode == 2 || mode == 4) rope_tile4(acc, p.tab(), row0, r, lh, mode == 1 ? 1.f : (mode == 2 ? 0.125f * LOG2E : 0.125f));
  if (mode == 3) {
#pragma unroll
    for (int mi = 0; mi < 4; ++mi)
#pragma unroll
      for (int ni = 0; ni < 2; ++ni)
#pragma unroll
        for (int i = 0; i < 16; ++i) { float g = acc[mi][ni][i]; acc[mi][ni][i] = g * sigmoidf_(g); }
  }
  if (rm_dst) stage_rm(acc, st, r, lh);
  __syncthreads();
  if (rm_dst) flush_rm(st, rm_dst, rm_ld, lane);
  __syncthreads();
  if (t_dst) {
    if (mode == 4) {
      const float l2g = ret_l2g((cw - 640) >> 6);
#pragma unroll
      for (int mi = 0; mi < 4; ++mi)
#pragma unroll
        for (int i = 0; i < 16; ++i) {
          int tl = (t0 + mi * 32 + crow(i, lh)) & 127;
          float zt = exp2f((float)(127 - tl) * l2g);
          acc[mi][0][i] *= zt; acc[mi][1][i] *= zt;
        }
    }
    stage_T(acc, st, r, lh);
  }
  __syncthreads();
  if (t_dst) flush_T(st, t_dst, lane);
}

DI void phase_inproj(const Params& p, int L, int* ctr, int* s_item, unsigned char* smem) {
  const bf16_t* Bt = p.winT() + (size_t)L * NINP * DM;
  for (;;) {
    int mt, nt;
    if (!xcd_tile(ctr, s_item, 128, 24, mt, nt)) break;
    f32x16 acc[4][2];
    ARowMajor af{p.xb(), DM, mt * 256};
    gemm_big(acc, af, Bt, DM, nt * 128, 16, smem, (PROBE_DRY && ctr >= p.ctr() + 512) ? PROBE_DM : 0);
    if (!(PROBE_DRY && ctr >= p.ctr() + 512)) epi_inproj(acc, mt * 256, nt * 128, p, smem);
  }
}

DI f32x16 qk_block(const bf16_t* sK, int ldk, int kb, const bf16x8 (&qf)[4], int r, int lh, float cinit = 0.f) {
  f32x16 s;
#pragma unroll
  for (int i = 0; i < 16; ++i) s[i] = cinit;
  const bf16_t* kp = sK + (kb * 32 + r) * ldk + 8 * lh;
#pragma unroll
  for (int s4 = 0; s4 < 4; ++s4) {
    bf16x8 a = *(const bf16x8*)(kp + 16 * s4);
    s = MFMA32(a, qf[s4], s);
  }
  return s;
}
DI void pv_block(f32x16 (&o)[2], const bf16_t* sVT, int ldv, int kb, const f32x16& pm, int r, int lh) {
#pragma unroll
  for (int sp = 0; sp < 2; ++sp) {
    uint4 pk;
    pk.x = pack2(pm[8 * sp + 0], pm[8 * sp + 1]);
    pk.y = pack2(pm[8 * sp + 2], pm[8 * sp + 3]);
    pk.z = pack2(pm[8 * sp + 4], pm[8 * sp + 5]);
    pk.w = pack2(pm[8 * sp + 6], pm[8 * sp + 7]);
    bf16x8 pb = __builtin_bit_cast(bf16x8, pk);
#pragma unroll
    for (int db = 0; db < 2; ++db) {
      const bf16_t* vp = sVT + (db * 32 + r) * ldv + kb * 32 + 16 * sp + 4 * lh;
      uint2 lo = *(const uint2*)vp;
      uint2 hi = *(const uint2*)(vp + 8);
      uint4 av = make_uint4(lo.x, lo.y, hi.x, hi.y);
      o[db] = MFMA32(__builtin_bit_cast(bf16x8, av), pb, o[db]);
    }
  }
}

template <int MODE>
DI void nsa_item(const Params& p, int item, unsigned char* smem, int u_lo = 0, int u_hi = 3) {
  const int tid = tid_(), lane = tid & 63, w = tid >> 6, r = lane & 31, lh = lane >> 5;
  const int tt = 31 - (item >> 4), bg = item & 15, b = bg >> 1, g = bg & 1;
  const int t0 = tt * 128;
  const int tq = t0 + w * 32 + r;
  const unsigned tok = (unsigned)b * SEQ + tq;
  bf16_t* sK = (bf16_t*)smem;
  bf16_t* sV = (bf16_t*)(smem + 2 * 64 * LDT * 2);
  float* impL = (float*)(smem + 4 * 64 * LDT * 2);
  u64* s_sel = (u64*)(smem + 4 * 64 * LDT * 2);

  const bf16_t* Kb; const bf16_t* Vb; int ldkg, ldvg;
  if (MODE == 0) { Kb = p.kwin() + (size_t)b * SEQ * 128 + g * 64; ldkg = 128; Vb = p.vwT() + (size_t)(b * 2 + g) * 64 * SEQ; ldvg = SEQ; }
  else if (MODE == 1) { Kb = p.kc() + (size_t)(b * 2 + g) * 256 * 64; ldkg = 64; Vb = p.vcT() + (size_t)(b * 2 + g) * 64 * 256; ldvg = 256; }
  else { Kb = p.kslc() + (size_t)b * SEQ * 128 + g * 64; ldkg = 128; Vb = p.vslT() + (size_t)(b * 2 + g) * 64 * SEQ; ldvg = SEQ; }

  u64 mysel = 0, umask = 0;
  int ntiles, kfirst;
  if (MODE == 0) { int klo = t0 - 512; if (klo < 0) klo = 0; kfirst = klo; ntiles = (t0 + 64 - klo) / 64 + 1; }
  else if (MODE == 1) {
    kfirst = 0; int nmax = (t0 + 96) >> 4; ntiles = nmax / 64 + 1; if (ntiles > 4) ntiles = 4;
    for (int i = tid; i < 128 * 65; i += 256) impL[i] = 0.f;
  } else {
    if (tid == 0) s_sel[128] = 0ull;
    __syncthreads();
    if (tid < 128) { u64 sv = p.sel()[(size_t)(b * 2 + g) * SEQ + t0 + tid]; s_sel[tid] = sv; atomicOr(&s_sel[128], sv); }
    __syncthreads();
    mysel = s_sel[w * 32 + r];
    umask = s_sel[128];
    const int jmax = (t0 + 127) >> 6;
    umask &= (jmax >= 63) ? ~0ull : ((1ull << (jmax + 1)) - 1ull);
    umask |= 1ull;
    ntiles = __popcll(umask);
    kfirst = 0;
  }

  constexpr int TP = (MODE == 1) ? 1 : 2;
  const int lrow = tid >> 3, lch = tid & 7;
  const bf16_t* kg0 = Kb + (size_t)lrow * ldkg + lch * 8;
  const bf16_t* kg1 = Kb + (size_t)(lrow + 32) * ldkg + lch * 8;
  const bf16_t* vg0 = Vb + (size_t)lrow * ldvg + lch * 8;
  const bf16_t* vg1 = Vb + (size_t)(lrow + 32) * ldvg + lch * 8;
  const int so0 = lrow * LDT + lch * 8, so1 = (lrow + 32) * LDT + lch * 8;
  uint4 rk0, rk1, rv0, rv1, rk2, rk3, rv2, rv3;
#define KV_GLOAD(keyA, keyB)                                   \
  {                                                            \
    rk0 = *(const uint4*)(kg0 + (size_t)(keyA) * ldkg);        \
    rk1 = *(const uint4*)(kg1 + (size_t)(keyA) * ldkg);        \
    rv0 = *(const uint4*)(vg0 + (keyA));                       \
    rv1 = *(const uint4*)(vg1 + (keyA));                       \
    if (TP == 2) {                                             \
      rk2 = *(const uint4*)(kg0 + (size_t)(keyB) * ldkg);      \
      rk3 = *(const uint4*)(kg1 + (size_t)(keyB) * ldkg);      \
      rv2 = *(const uint4*)(vg0 + (keyB));                     \
      rv3 = *(const uint4*)(vg1 + (keyB));                     \
    }                                                          \
  }
#define KV_SSTORE(stg)                                                     \
  {                                                                        \
    bf16_t* bK_ = sKV + ((stg) * TP) * 2 * 64 * LDT;                       \
    *(uint4*)(bK_ + so0) = rk0;                                            \
    *(uint4*)(bK_ + so1) = rk1;                                            \
    *(uint4*)(bK_ + 64 * LDT + so0) = rv0;                                 \
    *(uint4*)(bK_ + 64 * LDT + so1) = rv1;                                 \
    if (TP == 2) {                                                         \
      *(uint4*)(bK_ + 2 * 64 * LDT + so0) = rk2;                           \
      *(uint4*)(bK_ + 2 * 64 * LDT + so1) = rk3;                           \
      *(uint4*)(bK_ + 3 * 64 * LDT + so0) = rv2;                           \
      *(uint4*)(bK_ + 3 * 64 * LDT + so1) = rv3;                           \
    }                                                                      \
  }
  bf16_t* sKV = (bf16_t*)smem;

#pragma unroll 1
  for (int u = u_lo; u < u_hi; ++u) {
    const int hcol = (g * 3 + u) * 64;
    bf16x8 qf[4];
#pragma unroll
    for (int s = 0; s < 4; ++s) qf[s] = *(const bf16x8*)(p.qnsa() + (size_t)tok * 384 + hcol + 16 * s + 8 * lh);
    f32x16 o[2];
#pragma unroll
    for (int db = 0; db < 2; ++db)
#pragma unroll
      for (int i = 0; i < 16; ++i) o[db][i] = 0.f;
    float m = -1e30f, l = 0.f, invl = 0.f, carry = 0.f;

    const int npass = (MODE == 1) ? 2 : 1;
#pragma unroll 1
    for (int pass = 0; pass < npass; ++pass) {
      u64 rem = umask;
      int ka = kfirst, kb2 = kfirst + 64;
      bool vb = (TP == 2) && (ntiles > 1);
      if (MODE == 2) {
        rem &= rem - 1;
        vb = rem != 0ull;
        kb2 = vb ? (__builtin_ctzll(rem) << 6) : ka;
        rem &= rem - 1;
      }
      const int npairs = (ntiles + TP - 1) / TP;
      KV_GLOAD(ka, kb2);
      KV_SSTORE(0);
      __syncthreads();
#pragma unroll 1
      for (int ti = 0; ti < npairs; ++ti) {
        int na = (TP == 2 ? kb2 : ka) + 64, nb = na + 64;
        bool nvb = (TP == 2) && ((ti + 1) * 2 + 1 < ntiles);
        if (MODE == 2) {
          na = rem ? (__builtin_ctzll(rem) << 6) : 0; rem &= rem - 1;
          nvb = rem != 0ull;
          nb = nvb ? (__builtin_ctzll(rem) << 6) : na;
          rem &= rem - 1;
        }
        if (MODE == 0 && !nvb) nb = na;
        const bool more = ti + 1 < npairs;
        if (more) KV_GLOAD(na, nb);
#pragma unroll 1
        for (int half = 0; half < TP; ++half) {
        if (half == 1 && !vb) break;
        const int key_cur = half ? kb2 : ka;
        const bf16_t* cK = sKV + (((ti & 1) * TP + half) * 2) * 64 * LDT;
        const bf16_t* cV = cK + 64 * LDT;
        int lo, hi;
        if (MODE == 0) { hi = tq - key_cur; lo = tq - 511 - key_cur; }
        else if (MODE == 1) { hi = ((tq - 31) >> 4) - key_cur; lo = 0; }
        else { const int j = key_cur >> 6; hi = ((mysel >> j) & 1ull) ? (tq - key_cur) : -1; lo = 0; }
        const bool skip = (MODE != 1) && __all((hi < 0) || (lo > 63));
        const bool full = __all((lo <= 0) && (hi >= 63));
        const bool rowvalid = hi >= 0;
        const bool rowonly = !full && __all((hi < 0) || ((lo <= 0) && (hi >= 63)));
        if (!skip) {
          const int lo2 = lo - 4 * lh, hi2 = hi - 4 * lh;
          f32x16 S[2];
          bool fastdone = false;
          if (MODE != 1 && (full || rowonly) && __all(!rowvalid || m > -1e29f)) {
            const float cinit = rowvalid ? -m : -1e30f;
            S[0] = qk_block(cK, LDT, 0, qf, r, lh, cinit);
            S[1] = qk_block(cK, LDT, 1, qf, r, lh, cinit);
            float mxs = -1e30f;
#pragma unroll
            for (int kb = 0; kb < 2; ++kb)
#pragma unroll
              for (int i = 0; i < 16; ++i) mxs = fmaxf(mxs, S[kb][i]);
            if (__all(mxs <= 8.f)) {
              float rs = 0.f;
#pragma unroll
              for (int kb = 0; kb < 2; ++kb)
#pragma unroll
                for (int i = 0; i < 16; ++i) {
                  float pv = __builtin_amdgcn_exp2f(S[kb][i]);
                  S[kb][i] = pv;
                  rs += pv;
                }
              l += rs;
              pv_block(o, cV, LDT, 0, S[0], r, lh);
              pv_block(o, cV, LDT, 1, S[1], r, lh);
              fastdone = true;
            }
          }
          if (!fastdone) {
          S[0] = qk_block(cK, LDT, 0, qf, r, lh);
          S[1] = qk_block(cK, LDT, 1, qf, r, lh);
          if (!full && !rowonly) {
            asm volatile("" ::: "memory");
#pragma unroll
            for (int kb = 0; kb < 2; ++kb)
#pragma unroll
              for (int i = 0; i < 16; ++i) {
                const int c = kb * 32 + (i & 3) + 8 * (i >> 2);
                S[kb][i] = (c >= lo2 && c <= hi2) ? S[kb][i] : -1e30f;
              }
          }
          float mx = -1e30f;
#pragma unroll
          for (int kb = 0; kb < 2; ++kb)
#pragma unroll
            for (int i = 0; i < 16; ++i) mx = fmaxf(mx, S[kb][i]);
          if (rowonly) mx = rowvalid ? mx : -1e30f;
          if (MODE == 1 && pass == 1) {
            float mref = fmaxf(m, -1e20f);
            if (rowonly) mref = rowvalid ? mref : 1e30f;
#pragma unroll
            for (int kb = 0; kb < 2; ++kb)
#pragma unroll
              for (int i = 0; i < 16; ++i) S[kb][i] = __builtin_amdgcn_exp2f(S[kb][i] - mref) * invl;
#pragma unroll
            for (int kb = 0; kb < 2; ++kb)
#pragma unroll
              for (int gq = 0; gq < 4; ++gq) {
                float a = 2.f * (S[kb][4 * gq] + S[kb][4 * gq + 1] + S[kb][4 * gq + 2]) + S[kb][4 * gq + 3];
                float bq = S[kb][4 * gq + 3];
                float recv = xor32(bq);
                float tot;
                if (lh == 1) tot = a + recv;
                else { tot = a + carry; carry = recv; }
                const int j = (key_cur >> 2) + 8 * kb + 2 * gq + lh;
                impL[(w * 32 + r) * 65 + j] += tot;
              }
          } else {
            mx = fmaxf(mx, xor32(mx));
            const float mnew = fmaxf(m, mx);
            const float alpha = __builtin_amdgcn_exp2f(m - mnew);
            m = mnew;
            float mref = fmaxf(mnew, -1e20f);
            if (rowonly) mref = rowvalid ? mref : 1e30f;
            float rs = 0.f;
#pragma unroll
            for (int kb = 0; kb < 2; ++kb)
#pragma unroll
              for (int i = 0; i < 16; ++i) {
                float pv = __builtin_amdgcn_exp2f(S[kb][i] - mref);
                S[kb][i] = pv;
                rs += pv;
              }
            l = l * alpha + rs;
            if (MODE != 1) {
#pragma unroll
              for (int db = 0; db < 2; ++db)
#pragma unroll
                for (int i = 0; i < 16; ++i) o[db][i] *= alpha;
            }
          }
          if (!(MODE == 1 && pass == 0)) {
            pv_block(o, cV, LDT, 0, S[0], r, lh);
            pv_block(o, cV, LDT, 1, S[1], r, lh);
          }
          }
        }
        }
        if (more) KV_SSTORE((ti + 1) & 1);
        __syncthreads();
        ka = na; kb2 = nb; vb = nvb;
      }
      if (MODE == 1 && pass == 0) {
        float lt = l + xor32(l);
        invl = lt > 0.f ? 1.f / lt : 0.f;
      }
    }

    if (MODE == 1) {
      if (lh == 0) impL[(w * 32 + r) * 65 + 16 * ntiles] += carry;
#pragma unroll
      for (int db = 0; db < 2; ++db)
#pragma unroll
        for (int gq = 0; gq < 4; ++gq) {
          uint2 uu;
          uu.x = pack2(o[db][4 * gq], o[db][4 * gq + 1]);
          uu.y = pack2(o[db][4 * gq + 2], o[db][4 * gq + 3]);
          *(uint2*)(p.ocmp() + (size_t)tok * 384 + hcol + db * 32 + 8 * gq + 4 * lh) = uu;
        }
    } else {
      float lt = l + xor32(l);
      const float il = lt > 0.f ? 1.f / lt : 0.f;
      float g0 = 0.f, g1 = 0.f, g2 = 0.f;
      if (MODE == 2) {
        const float* gp = p.gates() + (size_t)tok * 18 + (g * 3 + u) * 3;
        g0 = gp[0]; g1 = gp[1]; g2 = gp[2];
      }
#pragma unroll
      for (int db = 0; db < 2; ++db)
#pragma unroll
        for (int gq = 0; gq < 4; ++gq) {
          const int d0 = db * 32 + 8 * gq + 4 * lh;
          float v0 = o[db][4 * gq] * il, v1 = o[db][4 * gq + 1] * il, v2 = o[db][4 * gq + 2] * il, v3 = o[db][4 * gq + 3] * il;
          bf16_t* yp = (MODE == 0) ? (p.owin() + (size_t)tok * 384 + hcol + d0) : (p.y() + (size_t)tok * DM + 640 + hcol + d0);
          if (MODE == 2) {
            uint2 oc = *(const uint2*)(p.ocmp() + (size_t)tok * 384 + hcol + d0);
            uint2 ow = *(const uint2*)(p.owin() + (size_t)tok * 384 + hcol + d0);
            v0 = g0 * bf2f((bf16_t)(oc.x & 0xffff)) + g1 * v0 + g2 * bf2f((bf16_t)(ow.x & 0xffff));
            v1 = g0 * bf2f((bf16_t)(oc.x >> 16)) + g1 * v1 + g2 * bf2f((bf16_t)(ow.x >> 16));
            v2 = g0 * bf2f((bf16_t)(oc.y & 0xffff)) + g1 * v2 + g2 * bf2f((bf16_t)(ow.y & 0xffff));
            v3 = g0 * bf2f((bf16_t)(oc.y >> 16)) + g1 * v3 + g2 * bf2f((bf16_t)(ow.y >> 16));
          }
          uint2 uu; uu.x = pack2(v0, v1); uu.y = pack2(v2, v3);
          *(uint2*)yp = uu;
        }
    }
  }
#undef KV_GLOAD
#undef KV_SSTORE

  if (MODE == 1) {
    __syncthreads();
#pragma unroll 1
    for (int q = 0; q < 32; ++q) {
      const int row = w * 32 + q;
      const int t = t0 + row;
      const int cur = t >> 6;
      u64 msk;
      if (cur < 16) {
        msk = (1ull << (cur + 1)) - 1ull;
      } else {
        float v = impL[row * 65 + lane];
        float sc = (lane <= cur) ? ((lane == 0 || lane == cur || lane == cur - 1) ? 1e6f : v) : -1.f;
        const unsigned ub = __float_as_uint(sc);
        const unsigned key = (ub & 0x80000000u) ? ~ub : (ub | 0x80000000u);
        unsigned T = 0u;
#pragma unroll 1
        for (int bit = 31; bit >= 0; --bit) {
          const unsigned cand = T | (1u << bit);
          if (__popcll(__ballot(key >= cand)) >= 16) T = cand;
        }
        msk = __ballot(key > T);
        u64 eq = __ballot(key == T);
        int remaining = 16 - __popcll(msk);
        while (remaining > 0 && eq) { msk |= eq & (~eq + 1ull); eq &= eq - 1ull; --remaining; }
      }
      if (lane == 0) p.sel()[(size_t)(b * 2 + g) * SEQ + t] = msk;
    }
  }
}

DI void retkv_item(const Params& p, int item) {
  const int tid = tid_(), lane = tid & 63, w = tid >> 6, r = lane & 31, lh = lane >> 5;
  const int n = item & 31, bh = item >> 5;
  const int eb = w >> 1, db = w & 1;
  f32x16 acc;
#pragma unroll
  for (int i = 0; i < 16; ++i) acc[i] = 0.f;
  const bf16_t* ap = p.vrT() + (size_t)(bh * 64 + eb * 32 + r) * SEQ + n * 128 + 8 * lh;
  const bf16_t* bp = p.kzT() + (size_t)(bh * 64 + db * 32 + r) * SEQ + n * 128 + 8 * lh;
#pragma unroll
  for (int s = 0; s < 8; ++s) {
    bf16x8 a = *(const bf16x8*)(ap + 16 * s);
    bf16x8 bb = *(const bf16x8*)(bp + 16 * s);
    acc = MFMA32(a, bb, acc);
  }
  float* dst = p.kvT() + (size_t)item * 4096;
#pragma unroll
  for (int i = 0; i < 16; ++i) dst[(eb * 32 + crow(i, lh)) * 64 + db * 32 + r] = acc[i];
}

DI void retscan_item(const Params& p, int item) {
  const int bh = item >> 4, part = item & 15, hd = bh % 6;
  const int idx = part * 256 + tid_();
  const float gc = exp2f(128.f * ret_l2g(hd));
  float kv[32];
#pragma unroll
  for (int n = 0; n < 32; ++n) kv[n] = p.kvT()[(size_t)(bh * 32 + n) * 4096 + idx];
  float st = 0.f;
#pragma unroll
  for (int n = 0; n < 32; ++n) {
    p.RT()[(size_t)(bh * 32 + n) * 4096 + idx] = f2bf(st);
    st = fmaf(gc, st, kv[n]);
  }
}

DI void retout_item(const Params& p, int L, int item, unsigned char* smem) {
  const int tid = tid_(), lane = tid & 63, w = tid >> 6, r = lane & 31, lh = lane >> 5;
  const int n = item & 31, bh = item >> 5, hd = bh % 6, b = bh / 6;
  constexpr int LDV2 = 136;
  bf16_t* sK = (bf16_t*)smem;
  bf16_t* sV = (bf16_t*)(smem + 128 * LDT * 2);
  const size_t tok0 = (size_t)b * SEQ + n * 128;
  {
    const int lrow = tid >> 3, lch = tid & 7;
#pragma unroll
    for (int c = 0; c < 4; ++c)
      *(uint4*)(sK + (lrow + 32 * c) * LDT + lch * 8) = *(const uint4*)(p.kret() + (tok0 + lrow + 32 * c) * 384 + hd * 64 + lch * 8);
    const int vrow = tid >> 4, vch = tid & 15;
#pragma unroll
    for (int c = 0; c < 4; ++c)
      *(uint4*)(sV + (vrow + 16 * c) * LDV2 + vch * 8) = *(const uint4*)(p.vrT() + (size_t)(bh * 64 + vrow + 16 * c) * SEQ + n * 128 + vch * 8);
  }
  const int iq = w * 32 + r;
  const size_t tok = tok0 + iq;
  bf16x8 qf[4];
#pragma unroll
  for (int s = 0; s < 4; ++s) qf[s] = *(const bf16x8*)(p.qret() + tok * 384 + hd * 64 + 16 * s + 8 * lh);
  const float l2g = ret_l2g(hd);
  f32x16 o[2];
#pragma unroll
  for (int db = 0; db < 2; ++db)
#pragma unroll
    for (int i = 0; i < 16; ++i) o[db][i] = 0.f;
  const bf16_t* rt = p.RT() + (size_t)item * 4096;
#pragma unroll
  for (int db = 0; db < 2; ++db)
#pragma unroll
    for (int s = 0; s < 4; ++s) {
      bf16x8 a = *(const bf16x8*)(rt + (db * 32 + r) * 64 + 16 * s + 8 * lh);
      o[db] = MFMA32(a, qf[s], o[db]);
    }
  const float xi = exp2f((float)(iq + 1) * l2g);
#pragma unroll
  for (int db = 0; db < 2; ++db)
#pragma unroll
    for (int i = 0; i < 16; ++i) o[db][i] *= xi;
  __syncthreads();
  for (int kb = 0; kb <= w; ++kb) {
    f32x16 S = qk_block(sK, LDT, kb, qf, r, lh);
#pragma unroll
    for (int i = 0; i < 16; ++i) {
      const int diff = iq - (kb * 32 + crow(i, lh));
      S[i] = diff >= 0 ? S[i] * __builtin_amdgcn_exp2f((float)diff * l2g) : 0.f;
    }
    pv_block(o, sV, LDV2, kb, S, r, lh);
  }
  float sm = 0.f;
#pragma unroll
  for (int db = 0; db < 2; ++db)
#pragma unroll
    for (int i = 0; i < 16; ++i) sm += o[db][i];
  sm += xor32(sm);
  const float mu = sm * (1.f / 64.f);
  float vs = 0.f;
#pragma unroll
  for (int db = 0; db < 2; ++db)
#pragma unroll
    for (int i = 0; i < 16; ++i) { float dd = o[db][i] - mu; vs += dd * dd; }
  vs += xor32(vs);
  const float rstd = rsqrtf(vs * (1.f / 64.f) + 1e-5f);
  const float* gng = p.gn_g + (size_t)L * 384 + hd * 64;
#pragma unroll
  for (int db = 0; db < 2; ++db)
#pragma unroll
    for (int gq = 0; gq < 4; ++gq) {
      const int d0 = db * 32 + 8 * gq + 4 * lh;
      uint2 sg = *(const uint2*)(p.gret() + tok * 384 + hd * 64 + d0);
      float4 gg = *(const float4*)(gng + d0);
      float v0 = (o[db][4 * gq] - mu) * rstd * gg.x * bf2f((bf16_t)(sg.x & 0xffff));
      float v1 = (o[db][4 * gq + 1] - mu) * rstd * gg.y * bf2f((bf16_t)(sg.x >> 16));
      float v2 = (o[db][4 * gq + 2] - mu) * rstd * gg.z * bf2f((bf16_t)(sg.y & 0xffff));
      float v3 = (o[db][4 * gq + 3] - mu) * rstd * gg.w * bf2f((bf16_t)(sg.y >> 16));
      uint2 uu; uu.x = pack2(v0, v1); uu.y = pack2(v2, v3);
      *(uint2*)(p.y() + tok * DM + 256 + hd * 64 + d0) = uu;
    }
}

DI void pool_item(const Params& p, int L, int item, unsigned char* smem) {
  const int tid = tid_(), lane = tid & 63, w = tid >> 6, r = lane & 31, lh = lane >> 5;
  const int gi = item & 3, tt = (item >> 2) & 63, b = item >> 8;
  const int t0 = tt * 64;
  float* sv = (float*)smem;
  bf16_t* am = (bf16_t*)(smem + 79 * 65 * 4 + 4);
  for (int idx = tid; idx < 79 * 8; idx += 256) {
    const int rr = idx >> 3, ch = idx & 7, ts = t0 - 15 + rr;
    uint4 u = make_uint4(0, 0, 0, 0);
    if (ts >= 0) u = *(const uint4*)(p.vpool() + ((size_t)b * SEQ + ts) * 256 + gi * 64 + ch * 8);
    float* d = sv + rr * 65 + ch * 8;
    d[0] = bf2f((bf16_t)(u.x & 0xffff)); d[1] = bf2f((bf16_t)(u.x >> 16)); d[2] = bf2f((bf16_t)(u.y & 0xffff)); d[3] = bf2f((bf16_t)(u.y >> 16));
    d[4] = bf2f((bf16_t)(u.z & 0xffff)); d[5] = bf2f((bf16_t)(u.z >> 16)); d[6] = bf2f((bf16_t)(u.w & 0xffff)); d[7] = bf2f((bf16_t)(u.w >> 16));
  }
  __syncthreads();
  const int win = 2 << gi;
  for (int idx = tid; idx < 4096; idx += 256) {
    const int tl = idx >> 6, c = idx & 63, t = t0 + tl;
    int lo = t + 1 - win; if (lo < 0) lo = 0;
    float s = 0.f;
    for (int u = lo; u <= t; ++u) s += sv[(u - t0 + 15) * 65 + c];
    am[tl * 72 + c] = f2bf(s / (float)(t + 1 - lo) - sv[(tl + 15) * 65 + c]);
  }
  __syncthreads();
  const int mb = w >> 1, nb = w & 1;
  f32x16 acc;
#pragma unroll
  for (int i = 0; i < 16; ++i) acc[i] = 0.f;
  const bf16_t* bp = p.pwT() + ((size_t)(L * 4 + gi) * 64 + nb * 32 + r) * 64 + 8 * lh;
#pragma unroll
  for (int s = 0; s < 4; ++s) {
    bf16x8 a = *(const bf16x8*)(am + (mb * 32 + r) * 72 + 16 * s + 8 * lh);
    bf16x8 bb = *(const bf16x8*)(bp + 16 * s);
    acc = MFMA32(a, bb, acc);
  }
  const int d = nb * 32 + r;
  const float scl = p.pool_scale[L * 256 + gi * 64 + d];
#pragma unroll
  for (int i = 0; i < 16; ++i)
    p.y()[((size_t)b * SEQ + t0 + mb * 32 + crow(i, lh)) * DM + gi * 64 + d] = f2bf(acc[i] * scl);
}

DI void compress_item(const Params& p, int L, int item, unsigned char* smem) {
  const int tid = tid_(), lane = tid & 63, w = tid >> 6, r = lane & 31, lh = lane >> 5;
  const int which = item >> 7, rest = item & 127, bg = rest >> 3, q = rest & 7, b = bg >> 1, g = bg & 1;
  const int i0 = q * 32;
  constexpr int LDC = 136;
  bf16_t* sA = (bf16_t*)smem;
  bf16_t* sB = (bf16_t*)(smem + 32 * LDC * 2);
  const bf16_t* src = (which ? p.vcmp() : p.kcmp()) + (size_t)b * SEQ * 128 + g * 64;
  const bf16_t* w1 = p.w1T() + (size_t)(L * 2 + which) * 128 * 2048;
  uint4 ra0, ra1, rb0, rb1, rb2, rb3, rb4, rb5, rb6, rb7;
  const int c16 = tid & 15, rowq = tid >> 4;
#define CLA(ra, c, it)                                                                                   \
  {                                                                                                      \
    const int ci = i0 + rowq + 16 * (c);                                                                 \
    const int l = 2 * (it) + (c16 >> 3);                                                                 \
    ra = (ci <= 254) ? *(const uint4*)(src + (size_t)(16 * ci + l) * 128 + (c16 & 7) * 8) : make_uint4(0, 0, 0, 0); \
  }
#define CLB(rb, c, it) { rb = *(const uint4*)(w1 + (size_t)(rowq + 16 * (c)) * 2048 + (it) * 128 + c16 * 8); }
#define CLOAD(it) { CLA(ra0, 0, it) CLA(ra1, 1, it) CLB(rb0, 0, it) CLB(rb1, 1, it) CLB(rb2, 2, it) CLB(rb3, 3, it) CLB(rb4, 4, it) CLB(rb5, 5, it) CLB(rb6, 6, it) CLB(rb7, 7, it) }
#define CSA(ra, c) { *(uint4*)(sA + (rowq + 16 * (c)) * LDC + c16 * 8) = ra; }
#define CSB(rb, c) { *(uint4*)(sB + (rowq + 16 * (c)) * LDC + c16 * 8) = rb; }
#define CSTORE() { CSA(ra0, 0) CSA(ra1, 1) CSB(rb0, 0) CSB(rb1, 1) CSB(rb2, 2) CSB(rb3, 3) CSB(rb4, 4) CSB(rb5, 5) CSB(rb6, 6) CSB(rb7, 7) }
  f32x16 acc;
#pragma unroll
  for (int i = 0; i < 16; ++i) acc[i] = 0.f;
  CLOAD(0);
  CSTORE();
  __syncthreads();
#pragma unroll 1
  for (int it = 0; it < 16; ++it) {
    const int i1 = (it + 1 < 16) ? it + 1 : 15;
    CLOAD(i1);
#pragma unroll
    for (int s = 0; s < 8; ++s) {
      bf16x8 a = *(const bf16x8*)(sA + r * LDC + 16 * s + 8 * lh);
      bf16x8 bb = *(const bf16x8*)(sB + (32 * w + r) * LDC + 16 * s + 8 * lh);
      acc = MFMA32(a, bb, acc);
    }
    __syncthreads();
    CSTORE();
    __syncthreads();
  }
#undef CLA
#undef CLB
#undef CLOAD
#undef CSA
#undef CSB
#undef CSTORE
  bf16_t* Hs = (bf16_t*)smem;
  {
    const int col = 32 * w + r;
    const float* c1 = p.c1() + (size_t)(L * 2 + which) * 64 * 128;
    float cb = ((which ? p.cb1_v : p.cb1_k) + (size_t)L * 128)[col];
    for (int kb = 0; kb < 64; ++kb) cb += c1[kb * 128 + col];
#pragma unroll
    for (int i = 0; i < 16; ++i) Hs[crow(i, lh) * LDC + col] = f2bf(gelu_tanh(acc[i] + cb));
  }
  __syncthreads();
  if (w == 0) {
    f32x16 o[2];
#pragma unroll
    for (int nb = 0; nb < 2; ++nb)
#pragma unroll
      for (int i = 0; i < 16; ++i) o[nb][i] = 0.f;
    const bf16_t* w2 = p.w2T() + (size_t)(L * 2 + which) * 64 * 128;
#pragma unroll
    for (int s = 0; s < 8; ++s) {
      bf16x8 a = *(const bf16x8*)(Hs + r * LDC + 16 * s + 8 * lh);
#pragma unroll
      for (int nb = 0; nb < 2; ++nb) {
        bf16x8 bb = *(const bf16x8*)(w2 + (nb * 32 + r) * 128 + 16 * s + 8 * lh);
        o[nb] = MFMA32(a, bb, o[nb]);
      }
    }
    if (which == 0) {
#pragma unroll
      for (int i = 0; i < 16; ++i) {
        const int ci = i0 + crow(i, lh);
        float v1 = 0.f, v2 = 0.f;
        if (ci <= 254) {
          float2 cs = p.tab()[((size_t)b * SEQ + 16 * ci + 31) * 32 + r];
          float x1 = o[0][i], x2 = o[1][i];
          v1 = x1 * cs.x - x2 * cs.y; v2 = x2 * cs.x + x1 * cs.y;
        }
        p.kc()[((size_t)bg * 256 + ci) * 64 + r] = f2bf(v1);
        p.kc()[((size_t)bg * 256 + ci) * 64 + 32 + r] = f2bf(v2);
      }
    } else {
#pragma unroll
      for (int nb = 0; nb < 2; ++nb)
#pragma unroll
        for (int gq = 0; gq < 4; ++gq) {
          uint2 uu;
          uu.x = pack2(o[nb][4 * gq], o[nb][4 * gq + 1]);
          uu.y = pack2(o[nb][4 * gq + 2], o[nb][4 * gq + 3]);
          *(uint2*)(p.vcT() + ((size_t)bg * 64 + nb * 32 + r) * 256 + i0 + 8 * gq + 4 * lh) = uu;
        }
    }
  }
}

DI void phase_mixA(const Params& p, int L, int* ctr, int* s_item, unsigned char* smem) {
  for (;;) {
    int item = next_item(ctr, s_item);
    if (item >= 256 + 1536 + 1536 + 2048) break;
    if (item < 256) compress_item(p, L, item, smem);
    else if (item < 256 + 1536) { const int q = item - 256, uu = q % 3; nsa_item<0>(p, q / 3, smem, uu, uu + 1); }
    else if (item < 256 + 1536 + 1536) retkv_item(p, item - 256 - 1536);
    else pool_item(p, L, item - 256 - 1536 - 1536, smem);
  }
}
DI void phase_mixB(const Params& p, int L, int* ctr, int* s_item, unsigned char* smem) {
  for (;;) {
    int item = next_item(ctr, s_item);
    if (item >= 512 + 768) break;
    if (item < 512) nsa_item<1>(p, item, smem);
    else retscan_item(p, item - 512);
  }
}
DI void phase_mixC(const Params& p, int L, int* ctr, int* s_item, unsigned char* smem) {
  for (;;) {
    int item = next_item(ctr, s_item);
    if (item >= 1536 + 1536) break;
    if (item < 1536) { const int uu = item % 3; nsa_item<2>(p, item / 3, smem, uu, uu + 1); }
    else retout_item(p, L, item - 1536, smem);
  }
}

DI void epi_resid(const f32x16 (&acc)[4][2], int m0, int n0, const Params& p, int mode, const float2* stats, const float* lg, const float* lb,
                  unsigned char* smem) {
  const int tid = tid_(), lane = tid & 63, w = tid >> 6, wm = w >> 1, wn = w & 1, r = lane & 31, lh = lane >> 5;
  constexpr int LDF = 68;
  float* st = (float*)(smem + w * (64 * LDF * 4));
  const int colbase = n0 + wn * 64;
  const int rr = lane >> 4, ch = lane & 15;
  const float4 gg = *(const float4*)(lg + colbase + ch * 4);
  const float4 bb = *(const float4*)(lb + colbase + ch * 4);
#pragma unroll
  for (int half = 0; half < 2; ++half) {
#pragma unroll
    for (int mh = 0; mh < 2; ++mh)
#pragma unroll
      for (int ni = 0; ni < 2; ++ni)
#pragma unroll
        for (int i = 0; i < 16; ++i) st[(mh * 32 + crow(i, lh)) * LDF + ni * 32 + r] = acc[half * 2 + mh][ni][i];
    __syncthreads();
#pragma unroll 8
    for (int k = 0; k < 16; ++k) {
      const int lrow = k * 4 + rr;
      const size_t row = (size_t)(m0 + wm * 128 + half * 64 + lrow);
      const float4 a = *(const float4*)(st + lrow * LDF + ch * 4);
      float* zp = p.z + row * DM + colbase + ch * 4;
      float4 res;
      if (mode == 0) res = *(const float4*)(p.x + row * DM + colbase + ch * 4);
      else {
        const float2 sv = stats[row];
        const float4 zz = *(const float4*)zp;
        res.x = (zz.x - sv.x) * sv.y * gg.x + bb.x; res.y = (zz.y - sv.x) * sv.y * gg.y + bb.y;
        res.z = (zz.z - sv.x) * sv.y * gg.z + bb.z; res.w = (zz.w - sv.x) * sv.y * gg.w + bb.w;
      }
      *(float4*)zp = make_float4(ALPHA * res.x + a.x, ALPHA * res.y + a.y, ALPHA * res.z + a.z, ALPHA * res.w + a.w);
    }
    __syncthreads();
  }
}

DI void phase_outproj(const Params& p, int L, int* ctr, int* s_item, unsigned char* smem) {
  const bf16_t* Bt = p.woutT() + (size_t)L * DM * DM;
  for (;;) {
    int mt, nt;
    if (!xcd_tile(ctr, s_item, 128, 8, mt, nt)) break;
    f32x16 acc[4][2];
    ARowMajor af{p.y(), DM, mt * 256};
    gemm_big(acc, af, Bt, DM, nt * 128, 16, smem);
    epi_resid(acc, mt * 256, nt * 128, p, L == 0 ? 0 : 1, p.stats2(), p.ln2g + (size_t)(L ? L - 1 : 0) * DM, p.ln2b + (size_t)(L ? L - 1 : 0) * DM, smem);
  }
}

DI void phase_ffn2(const Params& p, int L, int* ctr, int* s_item, unsigned char* smem) {
  const bf16_t* Bt = p.wdT() + (size_t)L * DM * DFF;
  for (;;) {
    int mt, nt;
    if (!xcd_tile(ctr, s_item, 128, 8, mt, nt)) break;
    f32x16 acc[4][2];
    ARowMajor af{p.act(), DFF, mt * 256};
    gemm_big(acc, af, Bt, DFF, nt * 128, 44, smem);
    epi_resid(acc, mt * 256, nt * 128, p, 1, p.stats1(), p.ln1g + (size_t)L * DM, p.ln1b + (size_t)L * DM, smem);
  }
}

struct AFfn1 {
  const bf16_t* xb; int tbase;
  DI const bf16_t* operator()(int row, int it) const {
    int ts = tbase + row;
    return (ts >= 0 && ts < SEQ) ? xb + (size_t)ts * DM + it * 64 : nullptr;
  }
};
DI void phase_ffn1(const Params& p, int L, int* ctr, int* s_item, unsigned char* smem) {
  const bf16_t* Bt = p.wguT() + (size_t)L * 2 * DFF * DM;
  constexpr int LDG = 65;
  float* sg = (float*)smem;
  for (;;) {
    int mt, nt;
    if (!xcd_tile(ctr, s_item, 136, 44, mt, nt)) break;
    const int b = mt / 17, it_ = mt % 17;
    const int tbase = 254 * it_ - 2;
    f32x16 acc[4][2];
    AFfn1 af{p.xb() + (size_t)b * SEQ * DM, tbase};
    gemm_big(acc, af, Bt, DM, nt * 128, 16, smem, (PROBE_DRY && ctr >= p.ctr() + 512) ? PROBE_DM : 0);
    if (PROBE_DRY && ctr >= p.ctr() + 512) { if (acc[0][0][0] == 12345.678f) sg[0] = acc[1][1][3] + acc[2][0][5] + acc[3][1][7]; continue; }
    const int tid = tid_(), lane = tid & 63, w = tid >> 6, wm = w >> 1, wn = w & 1, r = lane & 31, lh = lane >> 5;
#pragma unroll
    for (int mi = 0; mi < 4; ++mi)
#pragma unroll
      for (int i = 0; i < 16; ++i) sg[(wm * 128 + mi * 32 + crow(i, lh)) * LDG + wn * 32 + r] = acc[mi][0][i];
    __syncthreads();
    const float* cw = p.convw + (size_t)L * 3 * DFF;
    const int fl = wn * 32 + r;
    const int f = nt * 64 + fl;
    const float w0 = cw[f], w1 = cw[DFF + f], w2 = cw[2 * DFF + f], cb = p.convb[(size_t)L * DFF + f];
#pragma unroll
    for (int mi = 0; mi < 4; ++mi) {
#pragma unroll
      for (int gq = 0; gq < 4; ++gq) {
        const int rbase = wm * 128 + mi * 32 + 8 * gq + 4 * lh;
        float prev1 = rbase >= 1 ? sg[(rbase - 1) * LDG + fl] : 0.f;
        float prev2 = rbase >= 2 ? sg[(rbase - 2) * LDG + fl] : 0.f;
#pragma unroll
        for (int k = 0; k < 4; ++k) {
          const int rr = rbase + k, ts = tbase + rr;
          const float gv = acc[mi][0][4 * gq + k];
          const float hc = cb + w0 * prev2 + w1 * prev1 + w2 * gv;
          acc[mi][1][4 * gq + k] = gelu_tanh(hc) * acc[mi][1][4 * gq + k];
          prev2 = prev1; prev1 = gv;
        }
        __builtin_amdgcn_sched_barrier(0);
      }
    }
    __syncthreads();
    {
      constexpr int LDO = 40;
      bf16_t* so = (bf16_t*)(smem + w * (128 * LDO * 2));
#pragma unroll
      for (int mi = 0; mi < 4; ++mi)
#pragma unroll
        for (int i = 0; i < 16; ++i) so[(mi * 32 + crow(i, lh)) * LDO + r] = f2bf(acc[mi][1][i]);
      __syncthreads();
      const int lr = lane >> 2, ch = lane & 3;
      bf16_t* dst = p.act() + (size_t)b * SEQ * DFF + nt * 64 + wn * 32 + ch * 8;
#pragma unroll 8
      for (int k = 0; k < 8; ++k) {
        const int row = k * 16 + lr, rr = wm * 128 + row, ts = tbase + rr;
        if (rr >= 2 && ts < SEQ) *(uint4*)(dst + (size_t)ts * DFF) = *(const uint4*)(so + row * LDO + ch * 8);
      }
    }
  }
}

DI void phase_ln(const Params& p, const float* lg, const float* lb, float2* stats, bool final_) {
  const int tid = tid_(), lane = tid & 63, w = tid >> 6;
  for (int row0 = (blockIdx.x * 4 + w) * 2; row0 < MTOK; row0 += gridDim.x * 8) {
    float4 v[2][4];
#pragma unroll
    for (int rr = 0; rr < 2; ++rr)
#pragma unroll
      for (int c = 0; c < 4; ++c) v[rr][c] = *(const float4*)(p.z + (size_t)(row0 + rr) * DM + c * 256 + lane * 4);
#pragma unroll
    for (int rr = 0; rr < 2; ++rr) {
      const int row = row0 + rr;
      float* zr = p.z + (size_t)row * DM;
      float s = 0.f;
#pragma unroll
      for (int c = 0; c < 4; ++c) s += v[rr][c].x + v[rr][c].y + v[rr][c].z + v[rr][c].w;
#pragma unroll
      for (int off = 32; off >= 1; off >>= 1) s += __shfl_xor(s, off);
      const float mu = s * (1.f / 1024.f);
      float q = 0.f;
#pragma unroll
      for (int c = 0; c < 4; ++c) {
        float a = v[rr][c].x - mu, b = v[rr][c].y - mu, cc = v[rr][c].z - mu, d = v[rr][c].w - mu;
        q += a * a + b * b + cc * cc + d * d;
      }
#pragma unroll
      for (int off = 32; off >= 1; off >>= 1) q += __shfl_xor(q, off);
      const float rstd = rsqrtf(q * (1.f / 1024.f) + 1e-5f);
      if (lane == 0) stats[row] = make_float2(mu, rstd);
#pragma unroll
      for (int c = 0; c < 4; ++c) {
        const int col = c * 256 + lane * 4;
        float4 gg = *(const float4*)(lg + col), bb = *(const float4*)(lb + col);
        float o0 = (v[rr][c].x - mu) * rstd * gg.x + bb.x, o1 = (v[rr][c].y - mu) * rstd * gg.y + bb.y;
        float o2 = (v[rr][c].z - mu) * rstd * gg.z + bb.z, o3 = (v[rr][c].w - mu) * rstd * gg.w + bb.w;
        if (final_) *(float4*)(zr + col) = make_float4(o0, o1, o2, o3);
        else { uint2 u; u.x = pack2(o0, o1); u.y = pack2(o2, o3); *(uint2*)(p.xb() + (size_t)row * DM + col) = u; }
      }
    }
  }
}

__global__ void __launch_bounds__(256, 2) mega(Params p_, int ph_lo, int ph_hi) {
  __shared__ __attribute__((aligned(16))) unsigned char smem[73728];
  __shared__ int s_item;
  int rep = 0; int first = 1; int nbar = 0;
  for (int ph = ph_lo; ph < ph_hi; ++ph) {
#if COOP
    if (!first) {
      ++nbar;
      if (ph_hi < 0) cg::this_grid().sync();
      grid_bar((unsigned*)(p_.ctr() + 2048), (unsigned)nbar);
    }
    first = 0;
#endif
    const Params& p = p_;
    int* ctr = p.ctr() + ph * 8;
    if (ph == 0) { phase_prep(p, smem); continue; }
    const int L = (ph - 1) / 9, sub = (ph - 1) % 9;
#ifdef PROBE_MASK
    if (((PROBE_MASK >> sub) & 1) && !((sub == 4 || sub == 8) && L != 0) && sub != 7) {
      if (rep == 0) { --ph; rep = 1; ctr += 512; } else { rep = 0; }
    }
#endif
    switch (sub) {
      case 0: phase_inproj(p, L, ctr, &s_item, smem); break;
      case 1: phase_mixA(p, L, ctr, &s_item, smem); break;
      case 2: phase_mixB(p, L, ctr, &s_item, smem); break;
      case 3: phase_mixC(p, L, ctr, &s_item, smem); break;
      case 4: phase_outproj(p, L, ctr, &s_item, smem); break;
      case 5: phase_ln(p, p.ln1g + (size_t)L * DM, p.ln1b + (size_t)L * DM, p.stats1(), false); break;
      case 6: phase_ffn1(p, L, ctr, &s_item, smem); break;
      case 7: phase_ffn2(p, L, ctr, &s_item, smem); break;
      default: phase_ln(p, p.ln2g + (size_t)L * DM, p.ln2b + (size_t)L * DM, p.stats2(), L == 1); break;
    }
  }
}

extern "C" void kernel_launch(void* const* d_in, const int* in_sizes, int n_in, void* d_out, int out_size, void* d_ws, size_t ws_size,
                              hipStream_t stream) {
  Params p{};
  p.x = (const float*)d_in[0]; p.pos = (const int*)d_in[1]; p.w_in = (const float*)d_in[2]; p.w_out = (const float*)d_in[3];
  p.pool_w = (const float*)d_in[4]; p.pool_scale = (const float*)d_in[5]; p.gn_g = (const float*)d_in[6];
  p.cpos_k = (const float*)d_in[7]; p.cw1_k = (const float*)d_in[8]; p.cb1_k = (const float*)d_in[9]; p.cw2_k = (const float*)d_in[10];
  p.cpos_v = (const float*)d_in[11]; p.cw1_v = (const float*)d_in[12]; p.cb1_v = (const float*)d_in[13]; p.cw2_v = (const float*)d_in[14];
  p.wg = (const float*)d_in[15]; p.wu = (const float*)d_in[16]; p.convw = (const float*)d_in[17]; p.convb = (const float*)d_in[18];
  p.wd = (const float*)d_in[19]; p.ln1g = (const float*)d_in[20]; p.ln1b = (const float*)d_in[21]; p.ln2g = (const float*)d_in[22];
  p.ln2b = (const float*)d_in[23];
  p.z = (float*)d_out;
  p.ws = (unsigned char*)d_ws;
  if (WS_NEED > ws_size) { fprintf(stderr, "workspace too small: need %zu have %zu\n", (size_t)WS_NEED, ws_size); return; }

  (void)hipMemsetAsync(d_ws, 0, 16384, stream);
#if COOP
  static int grid_blocks = 0;
  if (!grid_blocks) {
    int dev = 0, cus = 0, per_cu = 0;
    hipGetDevice(&dev);
    hipDeviceGetAttribute(&cus, hipDeviceAttributeMultiprocessorCount, dev);
    hipOccupancyMaxActiveBlocksPerMultiprocessor(&per_cu, mega, 256, 0);
    if (per_cu > 2) per_cu = 2;
    grid_blocks = cus * per_cu;
  }
  int lo = 0, hi = NPHASE;
  void* args[] = {&p, &lo, &hi};
  hipError_t e = hipLaunchCooperativeKernel((void*)mega, dim3(grid_blocks), dim3(256), args, 0, stream);
  if (e != hipSuccess) fprintf(stderr, "cooperative launch failed: %s (grid %d)\n", hipGetErrorString(e), grid_blocks);
#else
  for (int ph = 0; ph < NPHASE; ++ph) mega<<<512, 256, 0, stream>>>(p, ph, ph + 1);
#endif
}
```

```cpp
#include <hip/hip_runtime.h>
#include <hip/hip_cooperative_groups.h>
#include <stdint.h>
#include <stdio.h>
namespace cg = cooperative_groups;

typedef unsigned short bf16_t;
typedef __attribute__((ext_vector_type(8))) short bf16x8;
typedef __attribute__((ext_vector_type(4))) short bf16x4;
typedef __attribute__((ext_vector_type(16))) float f32x16;
typedef __attribute__((ext_vector_type(2))) __bf16 bfv2;
typedef __attribute__((ext_vector_type(2))) float fv2;
typedef unsigned long long u64;
#define DI __device__ __forceinline__
#define MFMA32(a, b, c) __builtin_amdgcn_mfma_f32_32x32x16_bf16((a), (b), (c), 0, 0, 0)

#ifndef COOP
#define COOP 1
#ifndef PROBE_DRY
#define PROBE_DRY 0
#endif
#ifndef PROBE_DM
#define PROBE_DM 0
#endif
#endif

constexpr int MTOK = 32768, SEQ = 4096, DM = 1024, NIN = 2962, NINP = 3072, DFF = 2816;
constexpr float LOG2E = 1.4426950408889634f;
constexpr float ALPHA = 1.4142135623730951f;
constexpr int NPHASE = 19;

constexpr size_t al256(size_t v) { return (v + 255) & ~(size_t)255; }
constexpr size_t M_ = MTOK;
constexpr size_t OFF_ctr = 0;
constexpr size_t OFF_stats1 = OFF_ctr + al256(16384);
constexpr size_t OFF_stats2 = OFF_stats1 + al256(M_*8);
constexpr size_t OFF_tab = OFF_stats2 + al256(M_*8);
constexpr size_t OFF_c1 = OFF_tab + al256(M_*32*8);
constexpr size_t OFF_winT = OFF_c1 + al256(4*64*128*4);
constexpr size_t OFF_woutT = OFF_winT + al256((size_t)2*NINP*DM*2);
constexpr size_t OFF_wguT = OFF_woutT + al256((size_t)2*DM*DM*2);
constexpr size_t OFF_wdT = OFF_wguT + al256((size_t)2*2*DFF*DM*2);
constexpr size_t OFF_w1T = OFF_wdT + al256((size_t)2*DM*DFF*2);
constexpr size_t OFF_w2T = OFF_w1T + al256((size_t)4*128*2048*2);
constexpr size_t OFF_pwT = OFF_w2T + al256((size_t)4*64*128*2);
constexpr size_t OFF_xb = OFF_pwT + al256((size_t)8*64*64*2);
constexpr size_t OFF_y = OFF_xb + al256(M_*DM*2);
constexpr size_t OFF_ocmp = OFF_y + al256(M_*DM*2);
constexpr size_t OFF_owin = OFF_ocmp + al256(M_*384*2);
constexpr size_t OFF_gates = OFF_owin + al256(M_*384*2);
constexpr size_t OFF_kvT = OFF_gates + al256(M_*18*4);
constexpr size_t OFF_RT = OFF_kvT + al256((size_t)48*32*4096*4);
constexpr size_t OFF_kc = OFF_RT + al256((size_t)48*32*4096*2);
constexpr size_t OFF_vcT = OFF_kc + al256((size_t)16*256*64*2);
constexpr size_t OFF_sel = OFF_vcT + al256((size_t)16*64*256*2);
constexpr size_t OFF_vpool = OFF_sel + al256((size_t)16*SEQ*8);
constexpr size_t OFF_qret = OFF_vpool + al256(M_*256*2);
constexpr size_t OFF_kret = OFF_qret + al256(M_*384*2);
constexpr size_t OFF_kzT = OFF_kret + al256(M_*384*2);
constexpr size_t OFF_vrT = OFF_kzT + al256(M_*384*2);
constexpr size_t OFF_gret = OFF_vrT + al256(M_*384*2);
constexpr size_t OFF_qnsa = OFF_gret + al256(M_*384*2);
constexpr size_t OFF_kcmp = OFF_qnsa + al256(M_*384*2);
constexpr size_t OFF_vcmp = OFF_kcmp + al256(M_*128*2);
constexpr size_t OFF_kslc = OFF_vcmp + al256(M_*128*2);
constexpr size_t OFF_vslT = OFF_kslc + al256(M_*128*2);
constexpr size_t OFF_kwin = OFF_vslT + al256(M_*128*2);
constexpr size_t OFF_vwT = OFF_kwin + al256(M_*128*2);
constexpr size_t WS_NEED = OFF_vwT + al256(M_*128*2);
constexpr size_t OFF_act = OFF_vpool;
struct Params {
  const float* x; const int* pos; const float* w_in; const float* w_out; const float* pool_w; const float* pool_scale;
  const float* gn_g; const float* cpos_k; const float* cw1_k; const float* cb1_k; const float* cw2_k;
  const float* cpos_v; const float* cw1_v; const float* cb1_v; const float* cw2_v;
  const float* wg; const float* wu; const float* convw; const float* convb; const float* wd;
  const float* ln1g; const float* ln1b; const float* ln2g; const float* ln2b;
  float* z;
  unsigned char* ws;
  DI int* ctr() const { return (int*)(ws + OFF_ctr); }
  DI float2* stats1() const { return (float2*)(ws + OFF_stats1); }
  DI float2* stats2() const { return (float2*)(ws + OFF_stats2); }
  DI float2* tab() const { return (float2*)(ws + OFF_tab); }
  DI float* c1() const { return (float*)(ws + OFF_c1); }
  DI bf16_t* winT() const { return (bf16_t*)(ws + OFF_winT); }
  DI bf16_t* woutT() const { return (bf16_t*)(ws + OFF_woutT); }
  DI bf16_t* wguT() const { return (bf16_t*)(ws + OFF_wguT); }
  DI bf16_t* wdT() const { return (bf16_t*)(ws + OFF_wdT); }
  DI bf16_t* w1T() const { return (bf16_t*)(ws + OFF_w1T); }
  DI bf16_t* w2T() const { return (bf16_t*)(ws + OFF_w2T); }
  DI bf16_t* pwT() const { return (bf16_t*)(ws + OFF_pwT); }
  DI bf16_t* xb() const { return (bf16_t*)(ws + OFF_xb); }
  DI bf16_t* y() const { return (bf16_t*)(ws + OFF_y); }
  DI bf16_t* ocmp() const { return (bf16_t*)(ws + OFF_ocmp); }
  DI bf16_t* owin() const { return (bf16_t*)(ws + OFF_owin); }
  DI float* gates() const { return (float*)(ws + OFF_gates); }
  DI float* kvT() const { return (float*)(ws + OFF_kvT); }
  DI bf16_t* RT() const { return (bf16_t*)(ws + OFF_RT); }
  DI bf16_t* kc() const { return (bf16_t*)(ws + OFF_kc); }
  DI bf16_t* vcT() const { return (bf16_t*)(ws + OFF_vcT); }
  DI u64* sel() const { return (u64*)(ws + OFF_sel); }
  DI bf16_t* vpool() const { return (bf16_t*)(ws + OFF_vpool); }
  DI bf16_t* qret() const { return (bf16_t*)(ws + OFF_qret); }
  DI bf16_t* kret() const { return (bf16_t*)(ws + OFF_kret); }
  DI bf16_t* kzT() const { return (bf16_t*)(ws + OFF_kzT); }
  DI bf16_t* vrT() const { return (bf16_t*)(ws + OFF_vrT); }
  DI bf16_t* gret() const { return (bf16_t*)(ws + OFF_gret); }
  DI bf16_t* qnsa() const { return (bf16_t*)(ws + OFF_qnsa); }
  DI bf16_t* kcmp() const { return (bf16_t*)(ws + OFF_kcmp); }
  DI bf16_t* vcmp() const { return (bf16_t*)(ws + OFF_vcmp); }
  DI bf16_t* kslc() const { return (bf16_t*)(ws + OFF_kslc); }
  DI bf16_t* vslT() const { return (bf16_t*)(ws + OFF_vslT); }
  DI bf16_t* kwin() const { return (bf16_t*)(ws + OFF_kwin); }
  DI bf16_t* vwT() const { return (bf16_t*)(ws + OFF_vwT); }
  DI bf16_t* act() const { return (bf16_t*)(ws + OFF_act); }
};

DI int tid_() { int t = __builtin_amdgcn_workitem_id_x(); asm volatile("" : "+v"(t)); return t; }
DI unsigned pack2(float a, float b) { fv2 v = {a, b}; bfv2 r = __builtin_convertvector(v, bfv2); return __builtin_bit_cast(unsigned, r); }
DI bf16_t f2bf(float a) { return (bf16_t)(pack2(a, 0.f) & 0xffffu); }
DI float bf2f(bf16_t v) { return __uint_as_float(((unsigned)v) << 16); }
DI int crow(int i, int lh) { return (i & 3) + 8 * (i >> 2) + 4 * lh; }
DI float gelu_tanh(float x) {
  const float t = x * fmaf(x * x, 0.10294324f, 2.3022082f);
  return x * __builtin_amdgcn_rcpf(1.f + __builtin_amdgcn_exp2f(-t));
}
DI float sigmoidf_(float x) { return __builtin_amdgcn_rcpf(1.f + __builtin_amdgcn_exp2f(-x * LOG2E)); }
DI float xor32(float v) { return __shfl_xor(v, 32); }

DI int next_item(int* ctr, int* s_item) {
  __syncthreads();
  if (tid_() == 0) *s_item = atomicAdd(ctr, 1);
  __syncthreads();
  return *s_item;
}


DI void grid_bar(unsigned* bw, unsigned k) {
  asm volatile("s_waitcnt vmcnt(0)" ::: "memory");
  __syncthreads();
  if (tid_() == 0) {
    __builtin_amdgcn_fence(__ATOMIC_RELEASE, "agent");
    asm volatile("s_waitcnt vmcnt(0)" ::: "memory");
    const unsigned g = blockIdx.x & 7u, nloc = (gridDim.x - g + 7u) >> 3;
    const unsigned old = __hip_atomic_fetch_add(&bw[64 * g], 1u, __ATOMIC_RELAXED, __HIP_MEMORY_SCOPE_AGENT);
    if (old + 1u == k * nloc) {
      const unsigned ot = __hip_atomic_fetch_add(&bw[64 * 8], 1u, __ATOMIC_RELAXED, __HIP_MEMORY_SCOPE_AGENT);
      if (ot + 1u == k * 8u) __hip_atomic_fetch_add(&bw[64 * 9], 1u, __ATOMIC_RELAXED, __HIP_MEMORY_SCOPE_AGENT);
    }
    while (__hip_atomic_load(&bw[64 * 9], __ATOMIC_RELAXED, __HIP_MEMORY_SCOPE_AGENT) < k) __builtin_amdgcn_s_sleep(1);
    __builtin_amdgcn_fence(__ATOMIC_ACQUIRE, "agent");
    asm volatile("s_waitcnt vmcnt(0)" ::: "memory");
  }
  __syncthreads();
}

DI bool xcd_tile(int* ctr, int* s_item, int mtiles, int ntiles, int& mt, int& nt) {
  const int x = blockIdx.x & 7;
  const int q = next_item(ctr + x, s_item);
  const int per = mtiles >> 3;
  if (q >= per * ntiles) return false;
  const int fg = per >> 2, rem = per & 3;
  int ml;
  if (q < fg * 4 * ntiles) { const int g = q / (4 * ntiles), wq = q % (4 * ntiles); nt = wq >> 2; ml = 4 * g + (wq & 3); }
  else { const int q2 = q - fg * 4 * ntiles; nt = q2 / rem; ml = 4 * fg + q2 % rem; }
  mt = x * per + ml;
  return true;
}

constexpr int LDT = 72;
template <class AF>
DI void gemm_main(f32x16 (&acc)[2][2], AF af, const bf16_t* __restrict__ Bt, int ldb, int n0, int kiters, unsigned char* smem) {
  bf16_t* sA = (bf16_t*)smem;
  bf16_t* sB = (bf16_t*)(smem + 2 * 128 * LDT * 2);
  const int tid = tid_(), lane = tid & 63, w = tid >> 6, wm = w >> 1, wn = w & 1;
  const int r = lane & 31, lh = lane >> 5;
  const int lrow = tid >> 3, lch = tid & 7;
#pragma unroll
  for (int a = 0; a < 2; ++a)
#pragma unroll
    for (int b = 0; b < 2; ++b)
#pragma unroll
      for (int i = 0; i < 16; ++i) acc[a][b][i] = 0.f;
  uint4 ra[4], rb[4];
  const bf16_t* bptr = Bt + (size_t)(n0 + lrow) * ldb + lch * 8;
#define GLOAD(it)                                                                  \
  {                                                                                \
    _Pragma("unroll") for (int c = 0; c < 4; ++c) {                                \
      const bf16_t* pa = af(lrow + 32 * c, (it));                                  \
      ra[c] = pa ? *(const uint4*)(pa + lch * 8) : make_uint4(0, 0, 0, 0);         \
      rb[c] = *(const uint4*)(bptr + (size_t)(32 * c) * ldb + (it) * 64);          \
    }                                                                              \
  }
#define SSTORE(buf)                                                                \
  {                                                                                \
    _Pragma("unroll") for (int c = 0; c < 4; ++c) {                                \
      *(uint4*)(sA + (buf) * 128 * LDT + (lrow + 32 * c) * LDT + lch * 8) = ra[c]; \
      *(uint4*)(sB + (buf) * 128 * LDT + (lrow + 32 * c) * LDT + lch * 8) = rb[c]; \
    }                                                                              \
  }
  GLOAD(0);
  SSTORE(0);
  __syncthreads();
  for (int it = 0; it < kiters; ++it) {
    const int cur = it & 1;
    if (it + 1 < kiters) GLOAD(it + 1);
    const bf16_t* a_base = sA + cur * 128 * LDT + (wm * 64 + r) * LDT + 8 * lh;
    const bf16_t* b_base = sB + cur * 128 * LDT + (wn * 64 + r) * LDT + 8 * lh;
#pragma unroll
    for (int s = 0; s < 4; ++s) {
      bf16x8 a0 = *(const bf16x8*)(a_base + s * 16);
      bf16x8 a1 = *(const bf16x8*)(a_base + 32 * LDT + s * 16);
      bf16x8 b0 = *(const bf16x8*)(b_base + s * 16);
      bf16x8 b1 = *(const bf16x8*)(b_base + 32 * LDT + s * 16);
      acc[0][0] = MFMA32(a0, b0, acc[0][0]);
      acc[0][1] = MFMA32(a0, b1, acc[0][1]);
      acc[1][0] = MFMA32(a1, b0, acc[1][0]);
      acc[1][1] = MFMA32(a1, b1, acc[1][1]);
    }
    if (it + 1 < kiters) SSTORE(cur ^ 1);
    __syncthreads();
  }
#undef GLOAD
#undef SSTORE
}

template <class AF>
DI void gemm_big(f32x16 (&acc)[4][2], AF af, const bf16_t* __restrict__ Bt, int ldb, int n0, int kiters, unsigned char* smem, int dm = 0) {
  bf16_t* sA = (bf16_t*)smem;
  bf16_t* sB = (bf16_t*)(smem + 256 * LDT * 2);
  const int tid = tid_(), lane = tid & 63, w = tid >> 6, wm = w >> 1, wn = w & 1;
  const int r = lane & 31, lh = lane >> 5;
  const int lrow = tid >> 3, lch = tid & 7;
#pragma unroll
  for (int a = 0; a < 4; ++a)
#pragma unroll
    for (int b = 0; b < 2; ++b)
#pragma unroll
      for (int i = 0; i < 16; ++i) acc[a][b][i] = 0.f;
  uint4 ra0, ra1, ra2, ra3, ra4, ra5, ra6, ra7, rb0, rb1, rb2, rb3;
  const bf16_t* bptr = Bt + (size_t)(n0 + lrow) * ldb + lch * 8;
  const size_t bstep = (size_t)32 * ldb;
#define GLA(ra, c, it)                                                            \
  {                                                                               \
    const bf16_t* pa = af(lrow + 32 * (c), (it));                                 \
    ra = pa ? *(const uint4*)(pa + lch * 8) : make_uint4(0, 0, 0, 0);             \
  }
#define GLB(rb, c, it) { rb = *(const uint4*)(bptr + bstep * (c) + (it) * 64); }
#define GLOAD0(it)                                                                \
  {                                                                               \
    GLA(ra0, 0, it) GLA(ra1, 1, it) GLA(ra2, 2, it) GLA(ra3, 3, it)               \
    GLA(ra4, 4, it) GLA(ra5, 5, it) GLA(ra6, 6, it) GLA(ra7, 7, it)               \
    GLB(rb0, 0, it) GLB(rb1, 1, it) GLB(rb2, 2, it) GLB(rb3, 3, it)               \
  }
#define GLOAD1(it)                                                                \
  {                                                                               \
    GLA(qa0, 0, it) GLA(qa1, 1, it) GLA(qa2, 2, it) GLA(qa3, 3, it)               \
    GLA(qa4, 4, it) GLA(qa5, 5, it) GLA(qa6, 6, it) GLA(qa7, 7, it)               \
    GLB(qb0, 0, it) GLB(qb1, 1, it) GLB(qb2, 2, it) GLB(qb3, 3, it)               \
  }
#define SSA(ra, c, buf) { *(uint4*)(sA + (buf) * 256 * LDT + (lrow + 32 * (c)) * LDT + lch * 8) = ra; }
#define SSB(rb, c, buf) { *(uint4*)(sB + (buf) * 128 * LDT + (lrow + 32 * (c)) * LDT + lch * 8) = rb; }
#define SSTORE0(buf)                                                              \
  {                                                                               \
    SSA(ra0, 0, buf) SSA(ra1, 1, buf) SSA(ra2, 2, buf) SSA(ra3, 3, buf)           \
    SSA(ra4, 4, buf) SSA(ra5, 5, buf) SSA(ra6, 6, buf) SSA(ra7, 7, buf)           \
    SSB(rb0, 0, buf) SSB(rb1, 1, buf) SSB(rb2, 2, buf) SSB(rb3, 3, buf)           \
  }
#define SSTORE1(buf)                                                              \
  {                                                                               \
    SSA(qa0, 0, buf) SSA(qa1, 1, buf) SSA(qa2, 2, buf) SSA(qa3, 3, buf)           \
    SSA(qa4, 4, buf) SSA(qa5, 5, buf) SSA(qa6, 6, buf) SSA(qa7, 7, buf)           \
    SSB(qb0, 0, buf) SSB(qb1, 1, buf) SSB(qb2, 2, buf) SSB(qb3, 3, buf)           \
  }
#define COMPUTE(buf, LP0, LP1, LP2, LP3)                                                                     \
  {                                                                                                          \
    const bf16_t* a_base = sA + (buf) * 256 * LDT + (wm * 128 + r) * LDT + 8 * lh;                           \
    const bf16_t* b_base = sB + (buf) * 128 * LDT + (wn * 64 + r) * LDT + 8 * lh;                            \
    __builtin_amdgcn_s_setprio(1);                                                                           \
    _Pragma("unroll") for (int s = 0; s < 4; ++s) {                                                          \
      bf16x8 fa[4], fb[2];                                                                                   \
      _Pragma("unroll") for (int q = 0; q < 4; ++q) fa[q] = *(const bf16x8*)(a_base + q * 32 * LDT + s * 16); \
      _Pragma("unroll") for (int q = 0; q < 2; ++q) fb[q] = *(const bf16x8*)(b_base + q * 32 * LDT + s * 16); \
      if (s == 0) { LP0 } else if (s == 1) { LP1 } else if (s == 2) { LP2 } else { LP3 }                     \
      _Pragma("unroll") for (int mi = 0; mi < 4; ++mi)                                                       \
          _Pragma("unroll") for (int ni = 0; ni < 2; ++ni)                                                   \
              acc[mi][ni] = MFMA32(fa[mi], fb[ni], acc[mi][ni]);                                             \
      __builtin_amdgcn_sched_barrier(0);                                                                     \
    }                                                                                                        \
    __builtin_amdgcn_s_setprio(0);                                                                           \
  }
  GLOAD0(0);
  SSTORE0(0);
  __syncthreads();
  const int klast = kiters - 1;
#pragma unroll 1
  for (int it = 0; it < kiters; ++it) {
    const int i1 = (it + 1 < kiters) ? it + 1 : klast;
    COMPUTE(0, GLA(ra0, 0, i1) GLA(ra1, 1, i1) GLA(ra2, 2, i1), GLA(ra3, 3, i1) GLA(ra4, 4, i1) GLA(ra5, 5, i1),
            GLA(ra6, 6, i1) GLA(ra7, 7, i1) GLB(rb0, 0, i1), GLB(rb1, 1, i1) GLB(rb2, 2, i1) GLB(rb3, 3, i1));
    __syncthreads();
    SSTORE0(0);
    __syncthreads();
  }
#undef GLA
#undef GLB
#undef GLOAD0
#undef GLOAD1
#undef SSA
#undef SSB
#undef SSTORE0
#undef SSTORE1
#undef COMPUTE
}

struct ARowMajor {
  const bf16_t* A; int lda; int m0;
  DI const bf16_t* operator()(int row, int it) const { return A + (size_t)(m0 + row) * lda + it * 64; }
};

DI void store_rm(const f32x16 (&v)[2][2], bf16_t* dst, int ld, int row0, int col0, int r, int lh) {
#pragma unroll
  for (int mi = 0; mi < 2; ++mi)
#pragma unroll
    for (int ni = 0; ni < 2; ++ni)
#pragma unroll
      for (int i = 0; i < 16; ++i) dst[(size_t)(row0 + mi * 32 + crow(i, lh)) * ld + col0 + ni * 32 + r] = f2bf(v[mi][ni][i]);
}
DI void store_T(const f32x16 (&v)[2][2], bf16_t* dstT, int t0, int r, int lh) {
#pragma unroll
  for (int mi = 0; mi < 2; ++mi)
#pragma unroll
    for (int ni = 0; ni < 2; ++ni)
#pragma unroll
      for (int g = 0; g < 4; ++g) {
        uint2 u;
        u.x = pack2(v[mi][ni][4 * g], v[mi][ni][4 * g + 1]);
        u.y = pack2(v[mi][ni][4 * g + 2], v[mi][ni][4 * g + 3]);
        *(uint2*)(dstT + (size_t)(ni * 32 + r) * SEQ + t0 + mi * 32 + 8 * g + 4 * lh) = u;
      }
}
DI void rope_tile(f32x16 (&v)[2][2], const float2* tab, int row0, int r, int lh, float scale) {
#pragma unroll
  for (int mi = 0; mi < 2; ++mi)
#pragma unroll
    for (int i = 0; i < 16; ++i) {
      float2 cs = tab[(size_t)(row0 + mi * 32 + crow(i, lh)) * 32 + r];
      float x1 = v[mi][0][i], x2 = v[mi][1][i];
      v[mi][0][i] = (x1 * cs.x - x2 * cs.y) * scale;
      v[mi][1][i] = (x2 * cs.x + x1 * cs.y) * scale;
    }
}

constexpr int LDS_RM = 72;
constexpr int LDS_T = 136;
DI void stage_rm(const f32x16 (&v)[4][2], bf16_t* st, int r, int lh) {
#pragma unroll
  for (int mi = 0; mi < 4; ++mi)
#pragma unroll
    for (int ni = 0; ni < 2; ++ni)
#pragma unroll
      for (int i = 0; i < 16; ++i) st[(mi * 32 + crow(i, lh)) * LDS_RM + ni * 32 + r] = f2bf(v[mi][ni][i]);
}
DI void flush_rm(const bf16_t* st, bf16_t* dst, int ld, int lane) {
  const int rr = lane >> 3, ch = lane & 7;
#pragma unroll 4
  for (int k = 0; k < 16; ++k) {
    const int row = k * 8 + rr;
    *(uint4*)(dst + (size_t)row * ld + ch * 8) = *(const uint4*)(st + row * LDS_RM + ch * 8);
  }
}
DI void stage_T(const f32x16 (&v)[4][2], bf16_t* st, int r, int lh) {
#pragma unroll
  for (int mi = 0; mi < 4; ++mi)
#pragma unroll
    for (int ni = 0; ni < 2; ++ni)
#pragma unroll
      for (int g = 0; g < 4; ++g) {
        uint2 u;
        u.x = pack2(v[mi][ni][4 * g], v[mi][ni][4 * g + 1]);
        u.y = pack2(v[mi][ni][4 * g + 2], v[mi][ni][4 * g + 3]);
        *(uint2*)(st + (ni * 32 + r) * LDS_T + mi * 32 + 8 * g + 4 * lh) = u;
      }
}
DI void flush_T(const bf16_t* st, bf16_t* dstT, int lane) {
  const int dd = lane >> 4, ch = lane & 15;
#pragma unroll 4
  for (int k = 0; k < 16; ++k) {
    const int d = k * 4 + dd;
    *(uint4*)(dstT + (size_t)d * SEQ + ch * 8) = *(const uint4*)(st + d * LDS_T + ch * 8);
  }
}
DI void rope_tile4(f32x16 (&v)[4][2], const float2* tab, int row0, int r, int lh, float scale) {
#pragma unroll
  for (int mi = 0; mi < 4; ++mi) {
#pragma unroll
    for (int i = 0; i < 16; ++i) {
      float2 cs = tab[(size_t)(row0 + mi * 32 + crow(i, lh)) * 32 + r];
      float x1 = v[mi][0][i], x2 = v[mi][1][i];
      v[mi][0][i] = (x1 * cs.x - x2 * cs.y) * scale;
      v[mi][1][i] = (x2 * cs.x + x1 * cs.y) * scale;
    }
    __builtin_amdgcn_sched_barrier(0);
  }
}
DI float ret_l2g(int hd) { return log2f(1.f - exp2f(-(float)(5 + hd))); }

DI void conv_tile(const float* src, int N, bf16_t* dst, int ldd, int k0, int n0, int mode, float* st) {
  const int tid = tid_();
#pragma unroll
  for (int c = 0; c < 8; ++c) {
    const int idx = tid + 256 * c, kk = idx >> 5, n2 = idx & 31, n = n0 + 2 * n2;
    float2 v = make_float2(0.f, 0.f);
    if (n < N) v = *(const float2*)(src + (size_t)(k0 + kk) * N + n);
    st[kk * 65 + 2 * n2] = v.x;
    st[kk * 65 + 2 * n2 + 1] = v.y;
  }
  __syncthreads();
#pragma unroll
  for (int c = 0; c < 4; ++c) {
    const int idx = tid + 256 * c, nn = idx >> 4, k4 = idx & 15, n = n0 + nn;
    const int drow = (mode == 0) ? n : (64 * (n >> 5) + (mode == 2 ? 32 : 0) + (n & 31));
    uint2 u;
    u.x = pack2(st[(4 * k4) * 65 + nn], st[(4 * k4 + 1) * 65 + nn]);
    u.y = pack2(st[(4 * k4 + 2) * 65 + nn], st[(4 * k4 + 3) * 65 + nn]);
    *(uint2*)(dst + (size_t)drow * ldd + k0 + 4 * k4) = u;
  }
  __syncthreads();
}

DI void phase_prep(const Params& p, unsigned char* smem) {
  float* st = (float*)smem;
  const int tid = tid_();
  constexpr int PER = 3268;
  for (int idx = blockIdx.x; idx < 2 * PER; idx += gridDim.x) {
    int L = idx / PER, j = idx % PER;
    if (j < 768) { conv_tile(p.w_in + (size_t)L * DM * NIN, NIN, p.winT() + (size_t)L * NINP * DM, DM, (j / 48) * 64, (j % 48) * 64, 0, st); continue; }
    j -= 768;
    if (j < 256) { conv_tile(p.w_out + (size_t)L * DM * DM, DM, p.woutT() + (size_t)L * DM * DM, DM, (j / 16) * 64, (j % 16) * 64, 0, st); continue; }
    j -= 256;
    if (j < 704) { conv_tile(p.wg + (size_t)L * DM * DFF, DFF, p.wguT() + (size_t)L * 2 * DFF * DM, DM, (j / 44) * 64, (j % 44) * 64, 1, st); continue; }
    j -= 704;
    if (j < 704) { conv_tile(p.wu + (size_t)L * DM * DFF, DFF, p.wguT() + (size_t)L * 2 * DFF * DM, DM, (j / 44) * 64, (j % 44) * 64, 2, st); continue; }
    j -= 704;
    if (j < 704) { conv_tile(p.wd + (size_t)L * DFF * DM, DM, p.wdT() + (size_t)L * DM * DFF, DFF, (j / 16) * 64, (j % 16) * 64, 0, st); continue; }
    j -= 704;
    if (j < 64) { conv_tile(p.cw1_k + (size_t)L * 2048 * 128, 128, p.w1T() + (size_t)(L * 2 + 0) * 128 * 2048, 2048, (j / 2) * 64, (j % 2) * 64, 0, st); continue; }
    j -= 64;
    if (j < 64) { conv_tile(p.cw1_v + (size_t)L * 2048 * 128, 128, p.w1T() + (size_t)(L * 2 + 1) * 128 * 2048, 2048, (j / 2) * 64, (j % 2) * 64, 0, st); continue; }
    j -= 64;
    if (j < 2) { conv_tile(p.cw2_k + (size_t)L * 128 * 64, 64, p.w2T() + (size_t)(L * 2 + 0) * 64 * 128, 128, j * 64, 0, 0, st); continue; }
    j -= 2;
    conv_tile(p.cw2_v + (size_t)L * 128 * 64, 64, p.w2T() + (size_t)(L * 2 + 1) * 64 * 128, 128, j * 64, 0, 0, st);
  }
  for (int idx = blockIdx.x; idx < 8; idx += gridDim.x)
    conv_tile(p.pool_w + (size_t)idx * 4096, 64, p.pwT() + (size_t)idx * 4096, 64, 0, 0, 0, st);
  const size_t gtid = (size_t)blockIdx.x * 256 + tid, gstride = (size_t)gridDim.x * 256;
  for (size_t i = gtid; i < (size_t)MTOK * DM / 4; i += gstride) {
    float4 v = ((const float4*)p.x)[i];
    uint2 u; u.x = pack2(v.x, v.y); u.y = pack2(v.z, v.w);
    ((uint2*)p.xb())[i] = u;
  }
  for (size_t i = gtid; i < (size_t)MTOK * 32; i += gstride) {
    int tok = (int)(i >> 5), k = (int)(i & 31);
    float inv = exp2f(-(float)k * 0.41524101186092029f);
    float ang = (float)p.pos[tok] * inv;
    float kk = rintf(ang * 0.15915494309189535f);
    float rr = fmaf(-kk, 6.2831854820251465f, ang);
    rr = fmaf(-kk, -1.7484556000744883e-07f, rr);
    p.tab()[i] = make_float2(__cosf(rr), __sinf(rr));
  }
  for (int blk = blockIdx.x; blk < 256; blk += gridDim.x) {
    if (tid < 128) {
      const int lw = blk >> 6, kb = blk & 63, L = lw >> 1, which = lw & 1;
      const float* pe = (which ? p.cpos_v : p.cpos_k) + (size_t)L * 2048 + kb * 32;
      const float* w1 = (which ? p.cw1_v : p.cw1_k) + (size_t)L * 2048 * 128 + (size_t)kb * 32 * 128;
      float s = 0.f;
#pragma unroll 8
      for (int k = 0; k < 32; ++k) s = fmaf(pe[k], w1[(size_t)k * 128 + tid], s);
      p.c1()[(size_t)(lw * 64 + kb) * 128 + tid] = s;
    }
  }
}

DI void epi_inproj(f32x16 (&acc)[4][2], int m0, int n0, const Params& p, unsigned char* smem) {
  const int tid = tid_(), lane = tid & 63, w = tid >> 6, wm = w >> 1, wn = w & 1, r = lane & 31, lh = lane >> 5;
  const int cw = n0 + wn * 64;
  const int row0 = m0 + wm * 128;
  const int b = row0 >> 12, t0 = row0 & 4095;
  bf16_t* st = (bf16_t*)(smem + w * 18432);
  bf16_t* rm_dst = nullptr; int rm_ld = 0; bf16_t* t_dst = nullptr; int mode = 0;
  if (cw < 256) { rm_dst = p.vpool() + (size_t)row0 * 256 + cw; rm_ld = 256; }
  else if (cw < 640) { rm_dst = p.qret() + (size_t)row0 * 384 + (cw - 256); rm_ld = 384; mode = 1; }
  else if (cw < 1024) { rm_dst = p.kret() + (size_t)row0 * 384 + (cw - 640); rm_ld = 384; mode = 4; t_dst = p.kzT() + (size_t)((b * 6 + ((cw - 640) >> 6)) * 64) * SEQ + t0; }
  else if (cw < 1408) { t_dst = p.vrT() + (size_t)((b * 6 + ((cw - 1024) >> 6)) * 64) * SEQ + t0; }
  else if (cw < 1792) { rm_dst = p.gret() + (size_t)row0 * 384 + (cw - 1408); rm_ld = 384; mode = 3; }
  else if (cw < 2176) { rm_dst = p.qnsa() + (size_t)row0 * 384 + (cw - 1792); rm_ld = 384; mode = 2; }
  else if (cw < 2304) { rm_dst = p.kcmp() + (size_t)row0 * 128 + (cw - 2176); rm_ld = 128; }
  else if (cw < 2432) { rm_dst = p.vcmp() + (size_t)row0 * 128 + (cw - 2304); rm_ld = 128; }
  else if (cw < 2560) { rm_dst = p.kslc() + (size_t)row0 * 128 + (cw - 2432); rm_ld = 128; mode = 1; }
  else if (cw < 2688) { t_dst = p.vslT() + (size_t)((b * 2 + ((cw - 2560) >> 6)) * 64) * SEQ + t0; }
  else if (cw < 2816) { rm_dst = p.kwin() + (size_t)row0 * 128 + (cw - 2688); rm_ld = 128; mode = 1; }
  else if (cw < 2944) { t_dst = p.vwT() + (size_t)((b * 2 + ((cw - 2816) >> 6)) * 64) * SEQ + t0; }
  else if (cw == 2944) {
    if (r < 18) {
#pragma unroll
      for (int mi = 0; mi < 4; ++mi)
#pragma unroll
        for (int i = 0; i < 16; ++i) p.gates()[(size_t)(row0 + mi * 32 + crow(i, lh)) * 18 + r] = sigmoidf_(acc[mi][0][i]);
    }
  }
  if (mode == 1 || mode == 2 || mode == 4) rope_tile4(acc, p.tab(), row0, r, lh, mode == 1 ? 1.f : (mode == 2 ? 0.125f * LOG2E : 0.125f));
  if (mode == 3) {
#pragma unroll
    for (int mi = 0; mi < 4; ++mi)
#pragma unroll
      for (int ni = 0; ni < 2; ++ni)
#pragma unroll
        for (int i = 0; i < 16; ++i) { float g = acc[mi][ni][i]; acc[mi][ni][i] = g * sigmoidf_(g); }
  }
  if (rm_dst) stage_rm(acc, st, r, lh);
  __syncthreads();
  if (rm_dst) flush_rm(st, rm_dst, rm_ld, lane);
  __syncthreads();
  if (t_dst) {
    if (mode == 4) {
      const float l2g = ret_l2g((cw - 640) >> 6);
#pragma unroll
      for (int mi = 0; mi < 4; ++mi)
#pragma unroll
        for (int i = 0; i < 16; ++i) {
          int tl = (t0 + mi * 32 + crow(i, lh)) & 127;
          float zt = __builtin_amdgcn_exp2f((float)(127 - tl) * l2g);
          acc[mi][0][i] *= zt; acc[mi][1][i] *= zt;
        }
    }
    stage_T(acc, st, r, lh);
  }
  __syncthreads();
  if (t_dst) flush_T(st, t_dst, lane);
}

DI void phase_inproj(const Params& p, int L, int* ctr, int* s_item, unsigned char* smem) {
  const bf16_t* Bt = p.winT() + (size_t)L * NINP * DM;
  for (;;) {
    int mt, nt;
    if (!xcd_tile(ctr, s_item, 128, 24, mt, nt)) break;
    f32x16 acc[4][2];
    ARowMajor af{p.xb(), DM, mt * 256};
    gemm_big(acc, af, Bt, DM, nt * 128, 16, smem, (PROBE_DRY && ctr >= p.ctr() + 512) ? PROBE_DM : 0);
    if (!(PROBE_DRY && ctr >= p.ctr() + 512)) epi_inproj(acc, mt * 256, nt * 128, p, smem);
  }
}

DI f32x16 qk_block(const bf16_t* sK, int ldk, int kb, const bf16x8 (&qf)[4], int r, int lh, float cinit = 0.f) {
  f32x16 s;
#pragma unroll
  for (int i = 0; i < 16; ++i) s[i] = cinit;
  const bf16_t* kp = sK + (kb * 32 + r) * ldk + 8 * lh;
#pragma unroll
  for (int s4 = 0; s4 < 4; ++s4) {
    bf16x8 a = *(const bf16x8*)(kp + 16 * s4);
    s = MFMA32(a, qf[s4], s);
  }
  return s;
}
DI void pv_block(f32x16 (&o)[2], const bf16_t* sVT, int ldv, int kb, const f32x16& pm, int r, int lh) {
#pragma unroll
  for (int sp = 0; sp < 2; ++sp) {
    uint4 pk;
    pk.x = pack2(pm[8 * sp + 0], pm[8 * sp + 1]);
    pk.y = pack2(pm[8 * sp + 2], pm[8 * sp + 3]);
    pk.z = pack2(pm[8 * sp + 4], pm[8 * sp + 5]);
    pk.w = pack2(pm[8 * sp + 6], pm[8 * sp + 7]);
    bf16x8 pb = __builtin_bit_cast(bf16x8, pk);
#pragma unroll
    for (int db = 0; db < 2; ++db) {
      const bf16_t* vp = sVT + (db * 32 + r) * ldv + kb * 32 + 16 * sp + 4 * lh;
      uint2 lo = *(const uint2*)vp;
      uint2 hi = *(const uint2*)(vp + 8);
      uint4 av = make_uint4(lo.x, lo.y, hi.x, hi.y);
      o[db] = MFMA32(__builtin_bit_cast(bf16x8, av), pb, o[db]);
    }
  }
}

template <int MODE>
DI void nsa_item(const Params& p, int item, unsigned char* smem, int u_lo = 0, int u_hi = 3) {
  const int tid = tid_(), lane = tid & 63, w = tid >> 6, r = lane & 31, lh = lane >> 5;
  const int tt = 31 - (item >> 4), bg = item & 15, b = bg >> 1, g = bg & 1;
  const int t0 = tt * 128;
  const int tq = t0 + w * 32 + r;
  const unsigned tok = (unsigned)b * SEQ + tq;
  bf16_t* sK = (bf16_t*)smem;
  bf16_t* sV = (bf16_t*)(smem + 2 * 64 * LDT * 2);
  float* impL = (float*)(smem + 4 * 64 * LDT * 2);
  u64* s_sel = (u64*)(smem + 4 * 64 * LDT * 2);

  const bf16_t* Kb; const bf16_t* Vb; int ldkg, ldvg;
  if (MODE == 0) { Kb = p.kwin() + (size_t)b * SEQ * 128 + g * 64; ldkg = 128; Vb = p.vwT() + (size_t)(b * 2 + g) * 64 * SEQ; ldvg = SEQ; }
  else if (MODE == 1) { Kb = p.kc() + (size_t)(b * 2 + g) * 256 * 64; ldkg = 64; Vb = p.vcT() + (size_t)(b * 2 + g) * 64 * 256; ldvg = 256; }
  else { Kb = p.kslc() + (size_t)b * SEQ * 128 + g * 64; ldkg = 128; Vb = p.vslT() + (size_t)(b * 2 + g) * 64 * SEQ; ldvg = SEQ; }

  u64 mysel = 0, umask = 0;
  int ntiles, kfirst;
  if (MODE == 0) { int klo = t0 - 512; if (klo < 0) klo = 0; kfirst = klo; ntiles = (t0 + 64 - klo) / 64 + 1; }
  else if (MODE == 1) {
    kfirst = 0; int nmax = (t0 + 96) >> 4; ntiles = nmax / 64 + 1; if (ntiles > 4) ntiles = 4;
    for (int i = tid; i < 128 * 65; i += 256) impL[i] = 0.f;
  } else {
    if (tid == 0) s_sel[128] = 0ull;
    __syncthreads();
    if (tid < 128) { u64 sv = p.sel()[(size_t)(b * 2 + g) * SEQ + t0 + tid]; s_sel[tid] = sv; atomicOr(&s_sel[128], sv); }
    __syncthreads();
    mysel = s_sel[w * 32 + r];
    umask = s_sel[128];
    const int jmax = (t0 + 127) >> 6;
    umask &= (jmax >= 63) ? ~0ull : ((1ull << (jmax + 1)) - 1ull);
    umask |= 1ull;
    ntiles = __popcll(umask);
    kfirst = 0;
  }

  constexpr int TP = (MODE == 1) ? 1 : 2;
  const int lrow = tid >> 3, lch = tid & 7;
  const bf16_t* kg0 = Kb + (size_t)lrow * ldkg + lch * 8;
  const bf16_t* kg1 = Kb + (size_t)(lrow + 32) * ldkg + lch * 8;
  const bf16_t* vg0 = Vb + (size_t)lrow * ldvg + lch * 8;
  const bf16_t* vg1 = Vb + (size_t)(lrow + 32) * ldvg + lch * 8;
  const int so0 = lrow * LDT + lch * 8, so1 = (lrow + 32) * LDT + lch * 8;
  uint4 rk0, rk1, rv0, rv1, rk2, rk3, rv2, rv3;
#define KV_GLOAD(keyA, keyB)                                   \
  {                                                            \
    rk0 = *(const uint4*)(kg0 + (size_t)(keyA) * ldkg);        \
    rk1 = *(const uint4*)(kg1 + (size_t)(keyA) * ldkg);        \
    rv0 = *(const uint4*)(vg0 + (keyA));                       \
    rv1 = *(const uint4*)(vg1 + (keyA));                       \
    if (TP == 2) {                                             \
      rk2 = *(const uint4*)(kg0 + (size_t)(keyB) * ldkg);      \
      rk3 = *(const uint4*)(kg1 + (size_t)(keyB) * ldkg);      \
      rv2 = *(const uint4*)(vg0 + (keyB));                     \
      rv3 = *(const uint4*)(vg1 + (keyB));                     \
    }                                                          \
  }
#define KV_SSTORE(stg)                                                     \
  {                                                                        \
    bf16_t* bK_ = sKV + ((stg) * TP) * 2 * 64 * LDT;                       \
    *(uint4*)(bK_ + so0) = rk0;                                            \
    *(uint4*)(bK_ + so1) = rk1;                                            \
    *(uint4*)(bK_ + 64 * LDT + so0) = rv0;                                 \
    *(uint4*)(bK_ + 64 * LDT + so1) = rv1;                                 \
    if (TP == 2) {                                                         \
      *(uint4*)(bK_ + 2 * 64 * LDT + so0) = rk2;                           \
      *(uint4*)(bK_ + 2 * 64 * LDT + so1) = rk3;                           \
      *(uint4*)(bK_ + 3 * 64 * LDT + so0) = rv2;                           \
      *(uint4*)(bK_ + 3 * 64 * LDT + so1) = rv3;                           \
    }                                                                      \
  }
  bf16_t* sKV = (bf16_t*)smem;

#pragma unroll 1
  for (int u = u_lo; u < u_hi; ++u) {
    const int hcol = (g * 3 + u) * 64;
    bf16x8 qf[4];
#pragma unroll
    for (int s = 0; s < 4; ++s) qf[s] = *(const bf16x8*)(p.qnsa() + (size_t)tok * 384 + hcol + 16 * s + 8 * lh);
    f32x16 o[2];
#pragma unroll
    for (int db = 0; db < 2; ++db)
#pragma unroll
      for (int i = 0; i < 16; ++i) o[db][i] = 0.f;
    float m = -1e30f, l = 0.f, invl = 0.f, carry = 0.f;

    const int npass = (MODE == 1) ? 2 : 1;
#pragma unroll 1
    for (int pass = 0; pass < npass; ++pass) {
      u64 rem = umask;
      int ka = kfirst, kb2 = kfirst + 64;
      bool vb = (TP == 2) && (ntiles > 1);
      if (MODE == 2) {
        rem &= rem - 1;
        vb = rem != 0ull;
        kb2 = vb ? (__builtin_ctzll(rem) << 6) : ka;
        rem &= rem - 1;
      }
      const int npairs = (ntiles + TP - 1) / TP;
      KV_GLOAD(ka, kb2);
      KV_SSTORE(0);
      __syncthreads();
#pragma unroll 1
      for (int ti = 0; ti < npairs; ++ti) {
        int na = (TP == 2 ? kb2 : ka) + 64, nb = na + 64;
        bool nvb = (TP == 2) && ((ti + 1) * 2 + 1 < ntiles);
        if (MODE == 2) {
          na = rem ? (__builtin_ctzll(rem) << 6) : 0; rem &= rem - 1;
          nvb = rem != 0ull;
          nb = nvb ? (__builtin_ctzll(rem) << 6) : na;
          rem &= rem - 1;
        }
        if (MODE == 0 && !nvb) nb = na;
        const bool more = ti + 1 < npairs;
        if (more) KV_GLOAD(na, nb);
#pragma unroll 1
        for (int half = 0; half < TP; ++half) {
        if (half == 1 && !vb) break;
        const int key_cur = half ? kb2 : ka;
        const bf16_t* cK = sKV + (((ti & 1) * TP + half) * 2) * 64 * LDT;
        const bf16_t* cV = cK + 64 * LDT;
        int lo, hi;
        if (MODE == 0) { hi = tq - key_cur; lo = tq - 511 - key_cur; }
        else if (MODE == 1) { hi = ((tq - 31) >> 4) - key_cur; lo = 0; }
        else { const int j = key_cur >> 6; hi = ((mysel >> j) & 1ull) ? (tq - key_cur) : -1; lo = 0; }
        const bool skip = (MODE != 1) && __all((hi < 0) || (lo > 63));
        const bool full = __all((lo <= 0) && (hi >= 63));
        const bool rowvalid = hi >= 0;
        const bool rowonly = !full && __all((hi < 0) || ((lo <= 0) && (hi >= 63)));
        if (!skip) {
          const int lo2 = lo - 4 * lh, hi2 = hi - 4 * lh;
          f32x16 S[2];
          bool fastdone = false;
          if (MODE != 1 && (full || rowonly) && __all(!rowvalid || m > -1e29f)) {
            const float cinit = rowvalid ? -m : -1e30f;
            S[0] = qk_block(cK, LDT, 0, qf, r, lh, cinit);
            S[1] = qk_block(cK, LDT, 1, qf, r, lh, cinit);
            float mxs = -1e30f;
#pragma unroll
            for (int kb = 0; kb < 2; ++kb)
#pragma unroll
              for (int i = 0; i < 16; ++i) mxs = fmaxf(mxs, S[kb][i]);
            if (__all(mxs <= 8.f)) {
              float rs = 0.f;
#pragma unroll
              for (int kb = 0; kb < 2; ++kb)
#pragma unroll
                for (int i = 0; i < 16; ++i) {
                  float pv = __builtin_amdgcn_exp2f(S[kb][i]);
                  S[kb][i] = pv;
                  rs += pv;
                }
              l += rs;
              pv_block(o, cV, LDT, 0, S[0], r, lh);
              pv_block(o, cV, LDT, 1, S[1], r, lh);
              fastdone = true;
            }
          }
          if (!fastdone) {
          S[0] = qk_block(cK, LDT, 0, qf, r, lh);
          S[1] = qk_block(cK, LDT, 1, qf, r, lh);
          if (!full && !rowonly) {
            asm volatile("" ::: "memory");
#pragma unroll
            for (int kb = 0; kb < 2; ++kb)
#pragma unroll
              for (int i = 0; i < 16; ++i) {
                const int c = kb * 32 + (i & 3) + 8 * (i >> 2);
                S[kb][i] = (c >= lo2 && c <= hi2) ? S[kb][i] : -1e30f;
              }
          }
          float mx = -1e30f;
#pragma unroll
          for (int kb = 0; kb < 2; ++kb)
#pragma unroll
            for (int i = 0; i < 16; ++i) mx = fmaxf(mx, S[kb][i]);
          if (rowonly) mx = rowvalid ? mx : -1e30f;
          if (MODE == 1 && pass == 1) {
            float mref = fmaxf(m, -1e20f);
            if (rowonly) mref = rowvalid ? mref : 1e30f;
#pragma unroll
            for (int kb = 0; kb < 2; ++kb)
#pragma unroll
              for (int i = 0; i < 16; ++i) S[kb][i] = __builtin_amdgcn_exp2f(S[kb][i] - mref) * invl;
#pragma unroll
            for (int kb = 0; kb < 2; ++kb)
#pragma unroll
              for (int gq = 0; gq < 4; ++gq) {
                float a = 2.f * (S[kb][4 * gq] + S[kb][4 * gq + 1] + S[kb][4 * gq + 2]) + S[kb][4 * gq + 3];
                float bq = S[kb][4 * gq + 3];
                float recv = xor32(bq);
                float tot;
                if (lh == 1) tot = a + recv;
                else { tot = a + carry; carry = recv; }
                const int j = (key_cur >> 2) + 8 * kb + 2 * gq + lh;
                impL[(w * 32 + r) * 65 + j] += tot;
              }
          } else {
            mx = fmaxf(mx, xor32(mx));
            const float mnew = fmaxf(m, mx);
            const float alpha = __builtin_amdgcn_exp2f(m - mnew);
            m = mnew;
            float mref = fmaxf(mnew, -1e20f);
            if (rowonly) mref = rowvalid ? mref : 1e30f;
            float rs = 0.f;
#pragma unroll
            for (int kb = 0; kb < 2; ++kb)
#pragma unroll
              for (int i = 0; i < 16; ++i) {
                float pv = __builtin_amdgcn_exp2f(S[kb][i] - mref);
                S[kb][i] = pv;
                rs += pv;
              }
            l = l * alpha + rs;
            if (MODE != 1) {
#pragma unroll
              for (int db = 0; db < 2; ++db)
#pragma unroll
                for (int i = 0; i < 16; ++i) o[db][i] *= alpha;
            }
          }
          if (!(MODE == 1 && pass == 0)) {
            pv_block(o, cV, LDT, 0, S[0], r, lh);
            pv_block(o, cV, LDT, 1, S[1], r, lh);
          }
          }
        }
        }
        if (more) KV_SSTORE((ti + 1) & 1);
        __syncthreads();
        ka = na; kb2 = nb; vb = nvb;
      }
      if (MODE == 1 && pass == 0) {
        float lt = l + xor32(l);
        invl = lt > 0.f ? 1.f / lt : 0.f;
      }
    }

    if (MODE == 1) {
      if (lh == 0) impL[(w * 32 + r) * 65 + 16 * ntiles] += carry;
#pragma unroll
      for (int db = 0; db < 2; ++db)
#pragma unroll
        for (int gq = 0; gq < 4; ++gq) {
          uint2 uu;
          uu.x = pack2(o[db][4 * gq], o[db][4 * gq + 1]);
          uu.y = pack2(o[db][4 * gq + 2], o[db][4 * gq + 3]);
          *(uint2*)(p.ocmp() + (size_t)tok * 384 + hcol + db * 32 + 8 * gq + 4 * lh) = uu;
        }
    } else {
      float lt = l + xor32(l);
      const float il = lt > 0.f ? 1.f / lt : 0.f;
      float g0 = 0.f, g1 = 0.f, g2 = 0.f;
      if (MODE == 2) {
        const float* gp = p.gates() + (size_t)tok * 18 + (g * 3 + u) * 3;
        g0 = gp[0]; g1 = gp[1]; g2 = gp[2];
      }
#pragma unroll
      for (int db = 0; db < 2; ++db)
#pragma unroll
        for (int gq = 0; gq < 4; ++gq) {
          const int d0 = db * 32 + 8 * gq + 4 * lh;
          float v0 = o[db][4 * gq] * il, v1 = o[db][4 * gq + 1] * il, v2 = o[db][4 * gq + 2] * il, v3 = o[db][4 * gq + 3] * il;
          bf16_t* yp = (MODE == 0) ? (p.owin() + (size_t)tok * 384 + hcol + d0) : (p.y() + (size_t)tok * DM + 640 + hcol + d0);
          if (MODE == 2) {
            uint2 oc = *(const uint2*)(p.ocmp() + (size_t)tok * 384 + hcol + d0);
            uint2 ow = *(const uint2*)(p.owin() + (size_t)tok * 384 + hcol + d0);
            v0 = g0 * bf2f((bf16_t)(oc.x & 0xffff)) + g1 * v0 + g2 * bf2f((bf16_t)(ow.x & 0xffff));
            v1 = g0 * bf2f((bf16_t)(oc.x >> 16)) + g1 * v1 + g2 * bf2f((bf16_t)(ow.x >> 16));
            v2 = g0 * bf2f((bf16_t)(oc.y & 0xffff)) + g1 * v2 + g2 * bf2f((bf16_t)(ow.y & 0xffff));
            v3 = g0 * bf2f((bf16_t)(oc.y >> 16)) + g1 * v3 + g2 * bf2f((bf16_t)(ow.y >> 16));
          }
          uint2 uu; uu.x = pack2(v0, v1); uu.y = pack2(v2, v3);
          *(uint2*)yp = uu;
        }
    }
  }
#undef KV_GLOAD
#undef KV_SSTORE

  if (MODE == 1) {
    __syncthreads();
#pragma unroll 1
    for (int q = 0; q < 32; ++q) {
      const int row = w * 32 + q;
      const int t = t0 + row;
      const int cur = t >> 6;
      u64 msk;
      if (cur < 16) {
        msk = (1ull << (cur + 1)) - 1ull;
      } else {
        float v = impL[row * 65 + lane];
        float sc = (lane <= cur) ? ((lane == 0 || lane == cur || lane == cur - 1) ? 1e6f : v) : -1.f;
        const unsigned ub = __float_as_uint(sc);
        const unsigned key = (ub & 0x80000000u) ? ~ub : (ub | 0x80000000u);
        unsigned T = 0u;
#pragma unroll 1
        for (int bit = 31; bit >= 0; --bit) {
          const unsigned cand = T | (1u << bit);
          if (__popcll(__ballot(key >= cand)) >= 16) T = cand;
        }
        msk = __ballot(key > T);
        u64 eq = __ballot(key == T);
        int remaining = 16 - __popcll(msk);
        while (remaining > 0 && eq) { msk |= eq & (~eq + 1ull); eq &= eq - 1ull; --remaining; }
      }
      if (lane == 0) p.sel()[(size_t)(b * 2 + g) * SEQ + t] = msk;
    }
  }
}

DI void retkv_item(const Params& p, int item) {
  const int tid = tid_(), lane = tid & 63, w = tid >> 6, r = lane & 31, lh = lane >> 5;
  const int n = item & 31, bh = item >> 5;
  const int eb = w >> 1, db = w & 1;
  f32x16 acc;
#pragma unroll
  for (int i = 0; i < 16; ++i) acc[i] = 0.f;
  const bf16_t* ap = p.vrT() + (size_t)(bh * 64 + eb * 32 + r) * SEQ + n * 128 + 8 * lh;
  const bf16_t* bp = p.kzT() + (size_t)(bh * 64 + db * 32 + r) * SEQ + n * 128 + 8 * lh;
#pragma unroll
  for (int s = 0; s < 8; ++s) {
    bf16x8 a = *(const bf16x8*)(ap + 16 * s);
    bf16x8 bb = *(const bf16x8*)(bp + 16 * s);
    acc = MFMA32(a, bb, acc);
  }
  float* dst = p.kvT() + (size_t)item * 4096;
#pragma unroll
  for (int i = 0; i < 16; ++i) dst[(eb * 32 + crow(i, lh)) * 64 + db * 32 + r] = acc[i];
}

DI void retscan_item(const Params& p, int item) {
  const int bh = item >> 4, part = item & 15, hd = bh % 6;
  const int idx = part * 256 + tid_();
  const float gc = exp2f(128.f * ret_l2g(hd));
  float kv[32];
#pragma unroll
  for (int n = 0; n < 32; ++n) kv[n] = p.kvT()[(size_t)(bh * 32 + n) * 4096 + idx];
  float st = 0.f;
#pragma unroll
  for (int n = 0; n < 32; ++n) {
    p.RT()[(size_t)(bh * 32 + n) * 4096 + idx] = f2bf(st);
    st = fmaf(gc, st, kv[n]);
  }
}

DI void retout_item(const Params& p, int L, int item, unsigned char* smem) {
  const int tid = tid_(), lane = tid & 63, w = tid >> 6, r = lane & 31, lh = lane >> 5;
  const int n = item & 31, bh = item >> 5, hd = bh % 6, b = bh / 6;
  constexpr int LDV2 = 136;
  bf16_t* sK = (bf16_t*)smem;
  bf16_t* sV = (bf16_t*)(smem + 128 * LDT * 2);
  const size_t tok0 = (size_t)b * SEQ + n * 128;
  {
    const int lrow = tid >> 3, lch = tid & 7;
#pragma unroll
    for (int c = 0; c < 4; ++c)
      *(uint4*)(sK + (lrow + 32 * c) * LDT + lch * 8) = *(const uint4*)(p.kret() + (tok0 + lrow + 32 * c) * 384 + hd * 64 + lch * 8);
    const int vrow = tid >> 4, vch = tid & 15;
#pragma unroll
    for (int c = 0; c < 4; ++c)
      *(uint4*)(sV + (vrow + 16 * c) * LDV2 + vch * 8) = *(const uint4*)(p.vrT() + (size_t)(bh * 64 + vrow + 16 * c) * SEQ + n * 128 + vch * 8);
  }
  const int iq = w * 32 + r;
  const size_t tok = tok0 + iq;
  bf16x8 qf[4];
#pragma unroll
  for (int s = 0; s < 4; ++s) qf[s] = *(const bf16x8*)(p.qret() + tok * 384 + hd * 64 + 16 * s + 8 * lh);
  const float l2g = ret_l2g(hd);
  f32x16 o[2];
#pragma unroll
  for (int db = 0; db < 2; ++db)
#pragma unroll
    for (int i = 0; i < 16; ++i) o[db][i] = 0.f;
  const bf16_t* rt = p.RT() + (size_t)item * 4096;
#pragma unroll
  for (int db = 0; db < 2; ++db)
#pragma unroll
    for (int s = 0; s < 4; ++s) {
      bf16x8 a = *(const bf16x8*)(rt + (db * 32 + r) * 64 + 16 * s + 8 * lh);
      o[db] = MFMA32(a, qf[s], o[db]);
    }
  const float xi = exp2f((float)(iq + 1) * l2g);
#pragma unroll
  for (int db = 0; db < 2; ++db)
#pragma unroll
    for (int i = 0; i < 16; ++i) o[db][i] *= xi;
  __syncthreads();
  for (int kb = 0; kb <= w; ++kb) {
    f32x16 S = qk_block(sK, LDT, kb, qf, r, lh);
#pragma unroll
    for (int i = 0; i < 16; ++i) {
      const int diff = iq - (kb * 32 + crow(i, lh));
      S[i] = diff >= 0 ? S[i] * __builtin_amdgcn_exp2f((float)diff * l2g) : 0.f;
    }
    pv_block(o, sV, LDV2, kb, S, r, lh);
  }
  float sm = 0.f;
#pragma unroll
  for (int db = 0; db < 2; ++db)
#pragma unroll
    for (int i = 0; i < 16; ++i) sm += o[db][i];
  sm += xor32(sm);
  const float mu = sm * (1.f / 64.f);
  float vs = 0.f;
#pragma unroll
  for (int db = 0; db < 2; ++db)
#pragma unroll
    for (int i = 0; i < 16; ++i) { float dd = o[db][i] - mu; vs += dd * dd; }
  vs += xor32(vs);
  const float rstd = rsqrtf(vs * (1.f / 64.f) + 1e-5f);
  const float* gng = p.gn_g + (size_t)L * 384 + hd * 64;
#pragma unroll
  for (int db = 0; db < 2; ++db)
#pragma unroll
    for (int gq = 0; gq < 4; ++gq) {
      const int d0 = db * 32 + 8 * gq + 4 * lh;
      uint2 sg = *(const uint2*)(p.gret() + tok * 384 + hd * 64 + d0);
      float4 gg = *(const float4*)(gng + d0);
      float v0 = (o[db][4 * gq] - mu) * rstd * gg.x * bf2f((bf16_t)(sg.x & 0xffff));
      float v1 = (o[db][4 * gq + 1] - mu) * rstd * gg.y * bf2f((bf16_t)(sg.x >> 16));
      float v2 = (o[db][4 * gq + 2] - mu) * rstd * gg.z * bf2f((bf16_t)(sg.y & 0xffff));
      float v3 = (o[db][4 * gq + 3] - mu) * rstd * gg.w * bf2f((bf16_t)(sg.y >> 16));
      uint2 uu; uu.x = pack2(v0, v1); uu.y = pack2(v2, v3);
      *(uint2*)(p.y() + tok * DM + 256 + hd * 64 + d0) = uu;
    }
}

DI void pool_item(const Params& p, int L, int item, unsigned char* smem) {
  const int tid = tid_(), lane = tid & 63, w = tid >> 6, r = lane & 31, lh = lane >> 5;
  const int gi = item & 3, tt = (item >> 2) & 63, b = item >> 8;
  const int t0 = tt * 64;
  float* sv = (float*)smem;
  bf16_t* am = (bf16_t*)(smem + 79 * 65 * 4 + 4);
  for (int idx = tid; idx < 79 * 8; idx += 256) {
    const int rr = idx >> 3, ch = idx & 7, ts = t0 - 15 + rr;
    uint4 u = make_uint4(0, 0, 0, 0);
    if (ts >= 0) u = *(const uint4*)(p.vpool() + ((size_t)b * SEQ + ts) * 256 + gi * 64 + ch * 8);
    float* d = sv + rr * 65 + ch * 8;
    d[0] = bf2f((bf16_t)(u.x & 0xffff)); d[1] = bf2f((bf16_t)(u.x >> 16)); d[2] = bf2f((bf16_t)(u.y & 0xffff)); d[3] = bf2f((bf16_t)(u.y >> 16));
    d[4] = bf2f((bf16_t)(u.z & 0xffff)); d[5] = bf2f((bf16_t)(u.z >> 16)); d[6] = bf2f((bf16_t)(u.w & 0xffff)); d[7] = bf2f((bf16_t)(u.w >> 16));
  }
  __syncthreads();
  const int win = 2 << gi;
  for (int idx = tid; idx < 4096; idx += 256) {
    const int tl = idx >> 6, c = idx & 63, t = t0 + tl;
    int lo = t + 1 - win; if (lo < 0) lo = 0;
    float s = 0.f;
    for (int u = lo; u <= t; ++u) s += sv[(u - t0 + 15) * 65 + c];
    am[tl * 72 + c] = f2bf(s / (float)(t + 1 - lo) - sv[(tl + 15) * 65 + c]);
  }
  __syncthreads();
  const int mb = w >> 1, nb = w & 1;
  f32x16 acc;
#pragma unroll
  for (int i = 0; i < 16; ++i) acc[i] = 0.f;
  const bf16_t* bp = p.pwT() + ((size_t)(L * 4 + gi) * 64 + nb * 32 + r) * 64 + 8 * lh;
#pragma unroll
  for (int s = 0; s < 4; ++s) {
    bf16x8 a = *(const bf16x8*)(am + (mb * 32 + r) * 72 + 16 * s + 8 * lh);
    bf16x8 bb = *(const bf16x8*)(bp + 16 * s);
    acc = MFMA32(a, bb, acc);
  }
  const int d = nb * 32 + r;
  const float scl = p.pool_scale[L * 256 + gi * 64 + d];
#pragma unroll
  for (int i = 0; i < 16; ++i)
    p.y()[((size_t)b * SEQ + t0 + mb * 32 + crow(i, lh)) * DM + gi * 64 + d] = f2bf(acc[i] * scl);
}

DI void compress_item(const Params& p, int L, int item, unsigned char* smem) {
  const int tid = tid_(), lane = tid & 63, w = tid >> 6, r = lane & 31, lh = lane >> 5;
  const int which = item >> 7, rest = item & 127, bg = rest >> 3, q = rest & 7, b = bg >> 1, g = bg & 1;
  const int i0 = q * 32;
  constexpr int LDC = 136;
  bf16_t* sA = (bf16_t*)smem;
  bf16_t* sB = (bf16_t*)(smem + 32 * LDC * 2);
  const bf16_t* src = (which ? p.vcmp() : p.kcmp()) + (size_t)b * SEQ * 128 + g * 64;
  const bf16_t* w1 = p.w1T() + (size_t)(L * 2 + which) * 128 * 2048;
  uint4 ra0, ra1, rb0, rb1, rb2, rb3, rb4, rb5, rb6, rb7;
  const int c16 = tid & 15, rowq = tid >> 4;
#define CLA(ra, c, it)                                                                                   \
  {                                                                                                      \
    const int ci = i0 + rowq + 16 * (c);                                                                 \
    const int l = 2 * (it) + (c16 >> 3);                                                                 \
    ra = (ci <= 254) ? *(const uint4*)(src + (size_t)(16 * ci + l) * 128 + (c16 & 7) * 8) : make_uint4(0, 0, 0, 0); \
  }
#define CLB(rb, c, it) { rb = *(const uint4*)(w1 + (size_t)(rowq + 16 * (c)) * 2048 + (it) * 128 + c16 * 8); }
#define CLOAD(it) { CLA(ra0, 0, it) CLA(ra1, 1, it) CLB(rb0, 0, it) CLB(rb1, 1, it) CLB(rb2, 2, it) CLB(rb3, 3, it) CLB(rb4, 4, it) CLB(rb5, 5, it) CLB(rb6, 6, it) CLB(rb7, 7, it) }
#define CSA(ra, c) { *(uint4*)(sA + (rowq + 16 * (c)) * LDC + c16 * 8) = ra; }
#define CSB(rb, c) { *(uint4*)(sB + (rowq + 16 * (c)) * LDC + c16 * 8) = rb; }
#define CSTORE() { CSA(ra0, 0) CSA(ra1, 1) CSB(rb0, 0) CSB(rb1, 1) CSB(rb2, 2) CSB(rb3, 3) CSB(rb4, 4) CSB(rb5, 5) CSB(rb6, 6) CSB(rb7, 7) }
  f32x16 acc;
#pragma unroll
  for (int i = 0; i < 16; ++i) acc[i] = 0.f;
  CLOAD(0);
  CSTORE();
  __syncthreads();
#pragma unroll 1
  for (int it = 0; it < 16; ++it) {
    const int i1 = (it + 1 < 16) ? it + 1 : 15;
    CLOAD(i1);
#pragma unroll
    for (int s = 0; s < 8; ++s) {
      bf16x8 a = *(const bf16x8*)(sA + r * LDC + 16 * s + 8 * lh);
      bf16x8 bb = *(const bf16x8*)(sB + (32 * w + r) * LDC + 16 * s + 8 * lh);
      acc = MFMA32(a, bb, acc);
    }
    __syncthreads();
    CSTORE();
    __syncthreads();
  }
#undef CLA
#undef CLB
#undef CLOAD
#undef CSA
#undef CSB
#undef CSTORE
  bf16_t* Hs = (bf16_t*)smem;
  {
    const int col = 32 * w + r;
    const float* c1 = p.c1() + (size_t)(L * 2 + which) * 64 * 128;
    float cb = ((which ? p.cb1_v : p.cb1_k) + (size_t)L * 128)[col];
    for (int kb = 0; kb < 64; ++kb) cb += c1[kb * 128 + col];
#pragma unroll
    for (int i = 0; i < 16; ++i) Hs[crow(i, lh) * LDC + col] = f2bf(gelu_tanh(acc[i] + cb));
  }
  __syncthreads();
  if (w == 0) {
    f32x16 o[2];
#pragma unroll
    for (int nb = 0; nb < 2; ++nb)
#pragma unroll
      for (int i = 0; i < 16; ++i) o[nb][i] = 0.f;
    const bf16_t* w2 = p.w2T() + (size_t)(L * 2 + which) * 64 * 128;
#pragma unroll
    for (int s = 0; s < 8; ++s) {
      bf16x8 a = *(const bf16x8*)(Hs + r * LDC + 16 * s + 8 * lh);
#pragma unroll
      for (int nb = 0; nb < 2; ++nb) {
        bf16x8 bb = *(const bf16x8*)(w2 + (nb * 32 + r) * 128 + 16 * s + 8 * lh);
        o[nb] = MFMA32(a, bb, o[nb]);
      }
    }
    if (which == 0) {
#pragma unroll
      for (int i = 0; i < 16; ++i) {
        const int ci = i0 + crow(i, lh);
        float v1 = 0.f, v2 = 0.f;
        if (ci <= 254) {
          float2 cs = p.tab()[((size_t)b * SEQ + 16 * ci + 31) * 32 + r];
          float x1 = o[0][i], x2 = o[1][i];
          v1 = x1 * cs.x - x2 * cs.y; v2 = x2 * cs.x + x1 * cs.y;
        }
        p.kc()[((size_t)bg * 256 + ci) * 64 + r] = f2bf(v1);
        p.kc()[((size_t)bg * 256 + ci) * 64 + 32 + r] = f2bf(v2);
      }
    } else {
#pragma unroll
      for (int nb = 0; nb < 2; ++nb)
#pragma unroll
        for (int gq = 0; gq < 4; ++gq) {
          uint2 uu;
          uu.x = pack2(o[nb][4 * gq], o[nb][4 * gq + 1]);
          uu.y = pack2(o[nb][4 * gq + 2], o[nb][4 * gq + 3]);
          *(uint2*)(p.vcT() + ((size_t)bg * 64 + nb * 32 + r) * 256 + i0 + 8 * gq + 4 * lh) = uu;
        }
    }
  }
}

DI void phase_mixA(const Params& p, int L, int* ctr, int* s_item, unsigned char* smem) {
  for (;;) {
    int item = next_item(ctr, s_item);
    if (item >= 256 + 1536 + 1536 + 2048) break;
    if (item < 256) compress_item(p, L, item, smem);
    else if (item < 256 + 1536) { const int q = item - 256, uu = q % 3; nsa_item<0>(p, q / 3, smem, uu, uu + 1); }
    else if (item < 256 + 1536 + 1536) retkv_item(p, item - 256 - 1536);
    else pool_item(p, L, item - 256 - 1536 - 1536, smem);
  }
}
DI void phase_mixB(const Params& p, int L, int* ctr, int* s_item, unsigned char* smem) {
  for (;;) {
    int item = next_item(ctr, s_item);
    if (item >= 512 + 768) break;
    if (item < 512) nsa_item<1>(p, item, smem);
    else retscan_item(p, item - 512);
  }
}
DI void phase_mixC(const Params& p, int L, int* ctr, int* s_item, unsigned char* smem) {
  for (;;) {
    int item = next_item(ctr, s_item);
    if (item >= 1536 + 1536) break;
    if (item < 1536) { const int uu = item % 3; nsa_item<2>(p, item / 3, smem, uu, uu + 1); }
    else retout_item(p, L, item - 1536, smem);
  }
}

DI void epi_resid(const f32x16 (&acc)[4][2], int m0, int n0, const Params& p, int mode, const float2* stats, const float* lg, const float* lb,
                  unsigned char* smem) {
  const int tid = tid_(), lane = tid & 63, w = tid >> 6, wm = w >> 1, wn = w & 1, r = lane & 31, lh = lane >> 5;
  constexpr int LDF = 68;
  float* st = (float*)(smem + w * (64 * LDF * 4));
  const int colbase = n0 + wn * 64;
  const int rr = lane >> 4, ch = lane & 15;
  const float4 gg = *(const float4*)(lg + colbase + ch * 4);
  const float4 bb = *(const float4*)(lb + colbase + ch * 4);
#pragma unroll
  for (int half = 0; half < 2; ++half) {
#pragma unroll
    for (int mh = 0; mh < 2; ++mh)
#pragma unroll
      for (int ni = 0; ni < 2; ++ni)
#pragma unroll
        for (int i = 0; i < 16; ++i) st[(mh * 32 + crow(i, lh)) * LDF + ni * 32 + r] = acc[half * 2 + mh][ni][i];
    __syncthreads();
#pragma unroll 8
    for (int k = 0; k < 16; ++k) {
      const int lrow = k * 4 + rr;
      const size_t row = (size_t)(m0 + wm * 128 + half * 64 + lrow);
      const float4 a = *(const float4*)(st + lrow * LDF + ch * 4);
      float* zp = p.z + row * DM + colbase + ch * 4;
      float4 res;
      if (mode == 0) res = *(const float4*)(p.x + row * DM + colbase + ch * 4);
      else {
        const float2 sv = stats[row];
        const float4 zz = *(const float4*)zp;
        res.x = (zz.x - sv.x) * sv.y * gg.x + bb.x; res.y = (zz.y - sv.x) * sv.y * gg.y + bb.y;
        res.z = (zz.z - sv.x) * sv.y * gg.z + bb.z; res.w = (zz.w - sv.x) * sv.y * gg.w + bb.w;
      }
      *(float4*)zp = make_float4(ALPHA * res.x + a.x, ALPHA * res.y + a.y, ALPHA * res.z + a.z, ALPHA * res.w + a.w);
    }
    __syncthreads();
  }
}

DI void phase_outproj(const Params& p, int L, int* ctr, int* s_item, unsigned char* smem) {
  const bf16_t* Bt = p.woutT() + (size_t)L * DM * DM;
  for (;;) {
    int mt, nt;
    if (!xcd_tile(ctr, s_item, 128, 8, mt, nt)) break;
    f32x16 acc[4][2];
    ARowMajor af{p.y(), DM, mt * 256};
    gemm_big(acc, af, Bt, DM, nt * 128, 16, smem);
    epi_resid(acc, mt * 256, nt * 128, p, L == 0 ? 0 : 1, p.stats2(), p.ln2g + (size_t)(L ? L - 1 : 0) * DM, p.ln2b + (size_t)(L ? L - 1 : 0) * DM, smem);
  }
}

DI void phase_ffn2(const Params& p, int L, int* ctr, int* s_item, unsigned char* smem) {
  const bf16_t* Bt = p.wdT() + (size_t)L * DM * DFF;
  for (;;) {
    int mt, nt;
    if (!xcd_tile(ctr, s_item, 128, 8, mt, nt)) break;
    f32x16 acc[4][2];
    ARowMajor af{p.act(), DFF, mt * 256};
    gemm_big(acc, af, Bt, DFF, nt * 128, 44, smem);
    epi_resid(acc, mt * 256, nt * 128, p, 1, p.stats1(), p.ln1g + (size_t)L * DM, p.ln1b + (size_t)L * DM, smem);
  }
}

struct AFfn1 {
  const bf16_t* xb; int tbase;
  DI const bf16_t* operator()(int row, int it) const {
    int ts = tbase + row;
    return (ts >= 0 && ts < SEQ) ? xb + (size_t)ts * DM + it * 64 : nullptr;
  }
};
DI void phase_ffn1(const Params& p, int L, int* ctr, int* s_item, unsigned char* smem) {
  const bf16_t* Bt = p.wguT() + (size_t)L * 2 * DFF * DM;
  constexpr int LDG = 65;
  float* sg = (float*)smem;
  for (;;) {
    int mt, nt;
    if (!xcd_tile(ctr, s_item, 136, 44, mt, nt)) break;
    const int b = mt / 17, it_ = mt % 17;
    const int tbase = 254 * it_ - 2;
    f32x16 acc[4][2];
    AFfn1 af{p.xb() + (size_t)b * SEQ * DM, tbase};
    gemm_big(acc, af, Bt, DM, nt * 128, 16, smem, (PROBE_DRY && ctr >= p.ctr() + 512) ? PROBE_DM : 0);
    if (PROBE_DRY && ctr >= p.ctr() + 512) { if (acc[0][0][0] == 12345.678f) sg[0] = acc[1][1][3] + acc[2][0][5] + acc[3][1][7]; continue; }
    const int tid = tid_(), lane = tid & 63, w = tid >> 6, wm = w >> 1, wn = w & 1, r = lane & 31, lh = lane >> 5;
#pragma unroll
    for (int mi = 0; mi < 4; ++mi)
#pragma unroll
      for (int i = 0; i < 16; ++i) sg[(wm * 128 + mi * 32 + crow(i, lh)) * LDG + wn * 32 + r] = acc[mi][0][i];
    __syncthreads();
    const float* cw = p.convw + (size_t)L * 3 * DFF;
    const int fl = wn * 32 + r;
    const int f = nt * 64 + fl;
    const float w0 = cw[f], w1 = cw[DFF + f], w2 = cw[2 * DFF + f], cb = p.convb[(size_t)L * DFF + f];
#pragma unroll
    for (int mi = 0; mi < 4; ++mi) {
#pragma unroll
      for (int gq = 0; gq < 4; ++gq) {
        const int rbase = wm * 128 + mi * 32 + 8 * gq + 4 * lh;
        float prev1 = rbase >= 1 ? sg[(rbase - 1) * LDG + fl] : 0.f;
        float prev2 = rbase >= 2 ? sg[(rbase - 2) * LDG + fl] : 0.f;
#pragma unroll
        for (int k = 0; k < 4; ++k) {
          const int rr = rbase + k, ts = tbase + rr;
          const float gv = acc[mi][0][4 * gq + k];
          const float hc = cb + w0 * prev2 + w1 * prev1 + w2 * gv;
          acc[mi][1][4 * gq + k] = gelu_tanh(hc) * acc[mi][1][4 * gq + k];
          prev2 = prev1; prev1 = gv;
        }
        __builtin_amdgcn_sched_barrier(0);
      }
    }
    __syncthreads();
    {
      constexpr int LDO = 40;
      bf16_t* so = (bf16_t*)(smem + w * (128 * LDO * 2));
#pragma unroll
      for (int mi = 0; mi < 4; ++mi)
#pragma unroll
        for (int i = 0; i < 16; ++i) so[(mi * 32 + crow(i, lh)) * LDO + r] = f2bf(acc[mi][1][i]);
      __syncthreads();
      const int lr = lane >> 2, ch = lane & 3;
      bf16_t* dst = p.act() + (size_t)b * SEQ * DFF + nt * 64 + wn * 32 + ch * 8;
#pragma unroll 8
      for (int k = 0; k < 8; ++k) {
        const int row = k * 16 + lr, rr = wm * 128 + row, ts = tbase + rr;
        if (rr >= 2 && ts < SEQ) *(uint4*)(dst + (size_t)ts * DFF) = *(const uint4*)(so + row * LDO + ch * 8);
      }
    }
  }
}

DI void phase_ln(const Params& p, const float* lg, const float* lb, float2* stats, bool final_) {
  const int tid = tid_(), lane = tid & 63, w = tid >> 6;
  for (int row0 = (blockIdx.x * 4 + w) * 2; row0 < MTOK; row0 += gridDim.x * 8) {
    float4 v[2][4];
#pragma unroll
    for (int rr = 0; rr < 2; ++rr)
#pragma unroll
      for (int c = 0; c < 4; ++c) v[rr][c] = *(const float4*)(p.z + (size_t)(row0 + rr) * DM + c * 256 + lane * 4);
#pragma unroll
    for (int rr = 0; rr < 2; ++rr) {
      const int row = row0 + rr;
      float* zr = p.z + (size_t)row * DM;
      float s = 0.f;
#pragma unroll
      for (int c = 0; c < 4; ++c) s += v[rr][c].x + v[rr][c].y + v[rr][c].z + v[rr][c].w;
#pragma unroll
      for (int off = 32; off >= 1; off >>= 1) s += __shfl_xor(s, off);
      const float mu = s * (1.f / 1024.f);
      float q = 0.f;
#pragma unroll
      for (int c = 0; c < 4; ++c) {
        float a = v[rr][c].x - mu, b = v[rr][c].y - mu, cc = v[rr][c].z - mu, d = v[rr][c].w - mu;
        q += a * a + b * b + cc * cc + d * d;
      }
#pragma unroll
      for (int off = 32; off >= 1; off >>= 1) q += __shfl_xor(q, off);
      const float rstd = rsqrtf(q * (1.f / 1024.f) + 1e-5f);
      if (lane == 0) stats[row] = make_float2(mu, rstd);
#pragma unroll
      for (int c = 0; c < 4; ++c) {
        const int col = c * 256 + lane * 4;
        float4 gg = *(const float4*)(lg + col), bb = *(const float4*)(lb + col);
        float o0 = (v[rr][c].x - mu) * rstd * gg.x + bb.x, o1 = (v[rr][c].y - mu) * rstd * gg.y + bb.y;
        float o2 = (v[rr][c].z - mu) * rstd * gg.z + bb.z, o3 = (v[rr][c].w - mu) * rstd * gg.w + bb.w;
        if (final_) *(float4*)(zr + col) = make_float4(o0, o1, o2, o3);
        else { uint2 u; u.x = pack2(o0, o1); u.y = pack2(o2, o3); *(uint2*)(p.xb() + (size_t)row * DM + col) = u; }
      }
    }
  }
}

__global__ void __launch_bounds__(256, 2) mega(Params p_, int ph_lo, int ph_hi) {
  __shared__ __attribute__((aligned(16))) unsigned char smem[73728];
  __shared__ int s_item;
  int rep = 0; int first = 1; int nbar = 0;
  for (int ph = ph_lo; ph < ph_hi; ++ph) {
#if COOP
    if (!first) {
      ++nbar;
      if (ph_hi < 0) cg::this_grid().sync();
      grid_bar((unsigned*)(p_.ctr() + 2048), (unsigned)nbar);
    }
    first = 0;
#endif
    const Params& p = p_;
    int* ctr = p.ctr() + ph * 8;
    if (ph == 0) { phase_prep(p, smem); continue; }
    const int L = (ph - 1) / 9, sub = (ph - 1) % 9;
#ifdef PROBE_MASK
    if (((PROBE_MASK >> sub) & 1) && !((sub == 4 || sub == 8) && L != 0) && sub != 7) {
      if (rep == 0) { --ph; rep = 1; ctr += 512; } else { rep = 0; }
    }
#endif
    switch (sub) {
      case 0: phase_inproj(p, L, ctr, &s_item, smem); break;
      case 1: phase_mixA(p, L, ctr, &s_item, smem); break;
      case 2: phase_mixB(p, L, ctr, &s_item, smem); break;
      case 3: phase_mixC(p, L, ctr, &s_item, smem); break;
      case 4: phase_outproj(p, L, ctr, &s_item, smem); break;
      case 5: phase_ln(p, p.ln1g + (size_t)L * DM, p.ln1b + (size_t)L * DM, p.stats1(), false); break;
      case 6: phase_ffn1(p, L, ctr, &s_item, smem); break;
      case 7: phase_ffn2(p, L, ctr, &s_item, smem); break;
      default: phase_ln(p, p.ln2g + (size_t)L * DM, p.ln2b + (size_t)L * DM, p.stats2(), L == 1); break;
    }
  }
}

extern "C" void kernel_launch(void* const* d_in, const int* in_sizes, int n_in, void* d_out, int out_size, void* d_ws, size_t ws_size,
                              hipStream_t stream) {
  Params p{};
  p.x = (const float*)d_in[0]; p.pos = (const int*)d_in[1]; p.w_in = (const float*)d_in[2]; p.w_out = (const float*)d_in[3];
  p.pool_w = (const float*)d_in[4]; p.pool_scale = (const float*)d_in[5]; p.gn_g = (const float*)d_in[6];
  p.cpos_k = (const float*)d_in[7]; p.cw1_k = (const float*)d_in[8]; p.cb1_k = (const float*)d_in[9]; p.cw2_k = (const float*)d_in[10];
  p.cpos_v = (const float*)d_in[11]; p.cw1_v = (const float*)d_in[12]; p.cb1_v = (const float*)d_in[13]; p.cw2_v = (const float*)d_in[14];
  p.wg = (const float*)d_in[15]; p.wu = (const float*)d_in[16]; p.convw = (const float*)d_in[17]; p.convb = (const float*)d_in[18];
  p.wd = (const float*)d_in[19]; p.ln1g = (const float*)d_in[20]; p.ln1b = (const float*)d_in[21]; p.ln2g = (const float*)d_in[22];
  p.ln2b = (const float*)d_in[23];
  p.z = (float*)d_out;
  p.ws = (unsigned char*)d_ws;
  if (WS_NEED > ws_size) { fprintf(stderr, "workspace too small: need %zu have %zu\n", (size_t)WS_NEED, ws_size); return; }

  (void)hipMemsetAsync(d_ws, 0, 16384, stream);
#if COOP
  static int grid_blocks = 0;
  if (!grid_blocks) {
    int dev = 0, cus = 0, per_cu = 0;
    hipGetDevice(&dev);
    hipDeviceGetAttribute(&cus, hipDeviceAttributeMultiprocessorCount, dev);
    hipOccupancyMaxActiveBlocksPerMultiprocessor(&per_cu, mega, 256, 0);
    if (per_cu > 2) per_cu = 2;
    grid_blocks = cus * per_cu;
  }
  int lo = 0, hi = NPHASE;
  void* args[] = {&p, &lo, &hi};
  hipError_t e = hipLaunchCooperativeKernel((void*)mega, dim3(grid_blocks), dim3(256), args, 0, stream);
  if (e != hipSuccess) fprintf(stderr, "cooperative launch failed: %s (grid %d)\n", hipGetErrorString(e), grid_blocks);
#else
  for (int ph = 0; ph < NPHASE; ++ph) mega<<<512, 256, 0, stream>>>(p, ph, ph + 1);
#endif
}
```

```cpp
#include <hip/hip_runtime.h>
#include <hip/hip_cooperative_groups.h>
#include <stdint.h>
#include <stdio.h>
namespace cg = cooperative_groups;

typedef unsigned short bf16_t;
typedef __attribute__((ext_vector_type(8))) short bf16x8;
typedef __attribute__((ext_vector_type(4))) short bf16x4;
typedef __attribute__((ext_vector_type(16))) float f32x16;
typedef __attribute__((ext_vector_type(2))) __bf16 bfv2;
typedef __attribute__((ext_vector_type(2))) float fv2;
typedef unsigned long long u64;
#define DI __device__ __forceinline__
#define MFMA32(a, b, c) __builtin_amdgcn_mfma_f32_32x32x16_bf16((a), (b), (c), 0, 0, 0)

#ifndef COOP
#define COOP 1
#ifndef PROBE_DRY
#define PROBE_DRY 0
#endif
#ifndef PROBE_DM
#define PROBE_DM 0
#endif
#endif

constexpr int MTOK = 32768, SEQ = 4096, DM = 1024, NIN = 2962, NINP = 3072, DFF = 2816;
constexpr float LOG2E = 1.4426950408889634f;
constexpr float ALPHA = 1.4142135623730951f;
constexpr int NPHASE = 19;

constexpr size_t al256(size_t v) { return (v + 255) & ~(size_t)255; }
constexpr size_t M_ = MTOK;
constexpr size_t OFF_ctr = 0;
constexpr size_t OFF_stats1 = OFF_ctr + al256(16384);
constexpr size_t OFF_stats2 = OFF_stats1 + al256(M_*8);
constexpr size_t OFF_tab = OFF_stats2 + al256(M_*8);
constexpr size_t OFF_c1 = OFF_tab + al256(M_*32*8);
constexpr size_t OFF_winT = OFF_c1 + al256(4*64*128*4);
constexpr size_t OFF_woutT = OFF_winT + al256((size_t)2*NINP*DM*2);
constexpr size_t OFF_wguT = OFF_woutT + al256((size_t)2*DM*DM*2);
constexpr size_t OFF_wdT = OFF_wguT + al256((size_t)2*2*DFF*DM*2);
constexpr size_t OFF_w1T = OFF_wdT + al256((size_t)2*DM*DFF*2);
constexpr size_t OFF_w2T = OFF_w1T + al256((size_t)4*128*2048*2);
constexpr size_t OFF_pwT = OFF_w2T + al256((size_t)4*64*128*2);
constexpr size_t OFF_xb = OFF_pwT + al256((size_t)8*64*64*2);
constexpr size_t OFF_y = OFF_xb + al256(M_*DM*2);
constexpr size_t OFF_ocmp = OFF_y + al256(M_*DM*2);
constexpr size_t OFF_owin = OFF_ocmp + al256(M_*384*2);
constexpr size_t OFF_gates = OFF_owin + al256(M_*384*2);
constexpr size_t OFF_kvT = OFF_gates + al256(M_*18*4);
constexpr size_t OFF_RT = OFF_kvT + al256((size_t)48*32*4096*4);
constexpr size_t OFF_kc = OFF_RT + al256((size_t)48*32*4096*2);
constexpr size_t OFF_vcT = OFF_kc + al256((size_t)16*256*64*2);
constexpr size_t OFF_sel = OFF_vcT + al256((size_t)16*64*256*2);
constexpr size_t OFF_vpool = OFF_sel + al256((size_t)16*SEQ*8);
constexpr size_t OFF_qret = OFF_vpool + al256(M_*256*2);
constexpr size_t OFF_kret = OFF_qret + al256(M_*384*2);
constexpr size_t OFF_kzT = OFF_kret + al256(M_*384*2);
constexpr size_t OFF_vrT = OFF_kzT + al256(M_*384*2);
constexpr size_t OFF_gret = OFF_vrT + al256(M_*384*2);
constexpr size_t OFF_qnsa = OFF_gret + al256(M_*384*2);
constexpr size_t OFF_kcmp = OFF_qnsa + al256(M_*384*2);
constexpr size_t OFF_vcmp = OFF_kcmp + al256(M_*128*2);
constexpr size_t OFF_kslc = OFF_vcmp + al256(M_*128*2);
constexpr size_t OFF_vslT = OFF_kslc + al256(M_*128*2);
constexpr size_t OFF_kwin = OFF_vslT + al256(M_*128*2);
constexpr size_t OFF_vwT = OFF_kwin + al256(M_*128*2);
constexpr size_t WS_NEED = OFF_vwT + al256(M_*128*2);
constexpr size_t OFF_act = OFF_vpool;
struct Params {
  const float* x; const int* pos; const float* w_in; const float* w_out; const float* pool_w; const float* pool_scale;
  const float* gn_g; const float* cpos_k; const float* cw1_k; const float* cb1_k; const float* cw2_k;
  const float* cpos_v; const float* cw1_v; const float* cb1_v; const float* cw2_v;
  const float* wg; const float* wu; const float* convw; const float* convb; const float* wd;
  const float* ln1g; const float* ln1b; const float* ln2g; const float* ln2b;
  float* z;
  unsigned char* ws;
  DI int* ctr() const { return (int*)(ws + OFF_ctr); }
  DI float2* stats1() const { return (float2*)(ws + OFF_stats1); }
  DI float2* stats2() const { return (float2*)(ws + OFF_stats2); }
  DI float2* tab() const { return (float2*)(ws + OFF_tab); }
  DI float* c1() const { return (float*)(ws + OFF_c1); }
  DI bf16_t* winT() const { return (bf16_t*)(ws + OFF_winT); }
  DI bf16_t* woutT() const { return (bf16_t*)(ws + OFF_woutT); }
  DI bf16_t* wguT() const { return (bf16_t*)(ws + OFF_wguT); }
  DI bf16_t* wdT() const { return (bf16_t*)(ws + OFF_wdT); }
  DI bf16_t* w1T() const { return (bf16_t*)(ws + OFF_w1T); }
  DI bf16_t* w2T() const { return (bf16_t*)(ws + OFF_w2T); }
  DI bf16_t* pwT() const { return (bf16_t*)(ws + OFF_pwT); }
  DI bf16_t* xb() const { return (bf16_t*)(ws + OFF_xb); }
  DI bf16_t* y() const { return (bf16_t*)(ws + OFF_y); }
  DI bf16_t* ocmp() const { return (bf16_t*)(ws + OFF_ocmp); }
  DI bf16_t* owin() const { return (bf16_t*)(ws + OFF_owin); }
  DI float* gates() const { return (float*)(ws + OFF_gates); }
  DI float* kvT() const { return (float*)(ws + OFF_kvT); }
  DI bf16_t* RT() const { return (bf16_t*)(ws + OFF_RT); }
  DI bf16_t* kc() const { return (bf16_t*)(ws + OFF_kc); }
  DI bf16_t* vcT() const { return (bf16_t*)(ws + OFF_vcT); }
  DI u64* sel() const { return (u64*)(ws + OFF_sel); }
  DI bf16_t* vpool() const { return (bf16_t*)(ws + OFF_vpool); }
  DI bf16_t* qret() const { return (bf16_t*)(ws + OFF_qret); }
  DI bf16_t* kret() const { return (bf16_t*)(ws + OFF_kret); }
  DI bf16_t* kzT() const { return (bf16_t*)(ws + OFF_kzT); }
  DI bf16_t* vrT() const { return (bf16_t*)(ws + OFF_vrT); }
  DI bf16_t* gret() const { return (bf16_t*)(ws + OFF_gret); }
  DI bf16_t* qnsa() const { return (bf16_t*)(ws + OFF_qnsa); }
  DI bf16_t* kcmp() const { return (bf16_t*)(ws + OFF_kcmp); }
  DI bf16_t* vcmp() const { return (bf16_t*)(ws + OFF_vcmp); }
  DI bf16_t* kslc() const { return (bf16_t*)(ws + OFF_kslc); }
  DI bf16_t* vslT() const { return (bf16_t*)(ws + OFF_vslT); }
  DI bf16_t* kwin() const { return (bf16_t*)(ws + OFF_kwin); }
  DI bf16_t* vwT() const { return (bf16_t*)(ws + OFF_vwT); }
  DI bf16_t* act() const { return (bf16_t*)(ws + OFF_act); }
};

DI int tid_() { int t = __builtin_amdgcn_workitem_id_x(); asm volatile("" : "+v"(t)); return t; }
DI unsigned pack2(float a, float b) { fv2 v = {a, b}; bfv2 r = __builtin_convertvector(v, bfv2); return __builtin_bit_cast(unsigned, r); }
DI bf16_t f2bf(float a) { return (bf16_t)(pack2(a, 0.f) & 0xffffu); }
DI float bf2f(bf16_t v) { return __uint_as_float(((unsigned)v) << 16); }
DI int crow(int i, int lh) { return (i & 3) + 8 * (i >> 2) + 4 * lh; }
DI float gelu_tanh(float x) {
  const float t = x * fmaf(x * x, 0.10294324f, 2.3022082f);
  return x * __builtin_amdgcn_rcpf(1.f + __builtin_amdgcn_exp2f(-t));
}
DI float sigmoidf_(float x) { return __builtin_amdgcn_rcpf(1.f + __builtin_amdgcn_exp2f(-x * LOG2E)); }
DI float xor32(float v) { return __shfl_xor(v, 32); }

DI int next_item(int* ctr, int* s_item) {
  __syncthreads();
  if (tid_() == 0) *s_item = atomicAdd(ctr, 1);
  __syncthreads();
  return *s_item;
}


DI void grid_bar(unsigned* bw, unsigned k) {
  asm volatile("s_waitcnt vmcnt(0)" ::: "memory");
  __syncthreads();
  if (tid_() == 0) {
    __builtin_amdgcn_fence(__ATOMIC_RELEASE, "agent");
    asm volatile("s_waitcnt vmcnt(0)" ::: "memory");
    const unsigned g = blockIdx.x & 7u, nloc = (gridDim.x - g + 7u) >> 3;
    const unsigned old = __hip_atomic_fetch_add(&bw[64 * g], 1u, __ATOMIC_RELAXED, __HIP_MEMORY_SCOPE_AGENT);
    if (old + 1u == k * nloc) {
      const unsigned ot = __hip_atomic_fetch_add(&bw[64 * 8], 1u, __ATOMIC_RELAXED, __HIP_MEMORY_SCOPE_AGENT);
      if (ot + 1u == k * 8u) __hip_atomic_fetch_add(&bw[64 * 9], 1u, __ATOMIC_RELAXED, __HIP_MEMORY_SCOPE_AGENT);
    }
    while (__hip_atomic_load(&bw[64 * 9], __ATOMIC_RELAXED, __HIP_MEMORY_SCOPE_AGENT) < k) __builtin_amdgcn_s_sleep(1);
    __builtin_amdgcn_fence(__ATOMIC_ACQUIRE, "agent");
    asm volatile("s_waitcnt vmcnt(0)" ::: "memory");
  }
  __syncthreads();
}

DI bool xcd_tile(int* ctr, int* s_item, int mtiles, int ntiles, int& mt, int& nt) {
  const int x = blockIdx.x & 7;
  const int q = next_item(ctr + x, s_item);
  const int per = mtiles >> 3;
  if (q >= per * ntiles) return false;
  const int fg = per >> 2, rem = per & 3;
  int ml;
  if (q < fg * 4 * ntiles) { const int g = q / (4 * ntiles), wq = q % (4 * ntiles); nt = wq >> 2; ml = 4 * g + (wq & 3); }
  else { const int q2 = q - fg * 4 * ntiles; nt = q2 / rem; ml = 4 * fg + q2 % rem; }
  mt = x * per + ml;
  return true;
}

constexpr int LDT = 72;
template <class AF>
DI void gemm_main(f32x16 (&acc)[2][2], AF af, const bf16_t* __restrict__ Bt, int ldb, int n0, int kiters, unsigned char* smem) {
  bf16_t* sA = (bf16_t*)smem;
  bf16_t* sB = (bf16_t*)(smem + 2 * 128 * LDT * 2);
  const int tid = tid_(), lane = tid & 63, w = tid >> 6, wm = w >> 1, wn = w & 1;
  const int r = lane & 31, lh = lane >> 5;
  const int lrow = tid >> 3, lch = tid & 7;
#pragma unroll
  for (int a = 0; a < 2; ++a)
#pragma unroll
    for (int b = 0; b < 2; ++b)
#pragma unroll
      for (int i = 0; i < 16; ++i) acc[a][b][i] = 0.f;
  uint4 ra[4], rb[4];
  const bf16_t* bptr = Bt + (size_t)(n0 + lrow) * ldb + lch * 8;
#define GLOAD(it)                                                                  \
  {                                                                                \
    _Pragma("unroll") for (int c = 0; c < 4; ++c) {                                \
      const bf16_t* pa = af(lrow + 32 * c, (it));                                  \
      ra[c] = pa ? *(const uint4*)(pa + lch * 8) : make_uint4(0, 0, 0, 0);         \
      rb[c] = *(const uint4*)(bptr + (size_t)(32 * c) * ldb + (it) * 64);          \
    }                                                                              \
  }
#define SSTORE(buf)                                                                \
  {                                                                                \
    _Pragma("unroll") for (int c = 0; c < 4; ++c) {                                \
      *(uint4*)(sA + (buf) * 128 * LDT + (lrow + 32 * c) * LDT + lch * 8) = ra[c]; \
      *(uint4*)(sB + (buf) * 128 * LDT + (lrow + 32 * c) * LDT + lch * 8) = rb[c]; \
    }                                                                              \
  }
  GLOAD(0);
  SSTORE(0);
  __syncthreads();
  for (int it = 0; it < kiters; ++it) {
    const int cur = it & 1;
    if (it + 1 < kiters) GLOAD(it + 1);
    const bf16_t* a_base = sA + cur * 128 * LDT + (wm * 64 + r) * LDT + 8 * lh;
    const bf16_t* b_base = sB + cur * 128 * LDT + (wn * 64 + r) * LDT + 8 * lh;
#pragma unroll
    for (int s = 0; s < 4; ++s) {
      bf16x8 a0 = *(const bf16x8*)(a_base + s * 16);
      bf16x8 a1 = *(const bf16x8*)(a_base + 32 * LDT + s * 16);
      bf16x8 b0 = *(const bf16x8*)(b_base + s * 16);
      bf16x8 b1 = *(const bf16x8*)(b_base + 32 * LDT + s * 16);
      acc[0][0] = MFMA32(a0, b0, acc[0][0]);
      acc[0][1] = MFMA32(a0, b1, acc[0][1]);
      acc[1][0] = MFMA32(a1, b0, acc[1][0]);
      acc[1][1] = MFMA32(a1, b1, acc[1][1]);
    }
    if (it + 1 < kiters) SSTORE(cur ^ 1);
    __syncthreads();
  }
#undef GLOAD
#undef SSTORE
}

template <class AF>
DI void gemm_big(f32x16 (&acc)[4][2], AF af, const bf16_t* __restrict__ Bt, int ldb, int n0, int kiters, unsigned char* smem, int dm = 0) {
  bf16_t* sA = (bf16_t*)smem;
  bf16_t* sB = (bf16_t*)(smem + 256 * LDT * 2);
  const int tid = tid_(), lane = tid & 63, w = tid >> 6, wm = w >> 1, wn = w & 1;
  const int r = lane & 31, lh = lane >> 5;
  const int lrow = tid >> 3, lch = tid & 7;
#pragma unroll
  for (int a = 0; a < 4; ++a)
#pragma unroll
    for (int b = 0; b < 2; ++b)
#pragma unroll
      for (int i = 0; i < 16; ++i) acc[a][b][i] = 0.f;
  uint4 ra0, ra1, ra2, ra3, ra4, ra5, ra6, ra7, rb0, rb1, rb2, rb3;
  const bf16_t* bptr = Bt + (size_t)(n0 + lrow) * ldb + lch * 8;
  const size_t bstep = (size_t)32 * ldb;
#define GLA(ra, c, it)                                                            \
  {                                                                               \
    const bf16_t* pa = af(lrow + 32 * (c), (it));     \
    ra = *(const uint4*)(pa + lch * 8);                                           \
  }
#define GLB(rb, c, it) { rb = *(const uint4*)(bptr + bstep * (c) + (it) * 64); }
#define GLOAD0(it)                                                                \
  {                                                                               \
    GLA(ra0, 0, it) GLA(ra1, 1, it) GLA(ra2, 2, it) GLA(ra3, 3, it)               \
    GLA(ra4, 4, it) GLA(ra5, 5, it) GLA(ra6, 6, it) GLA(ra7, 7, it)               \
    GLB(rb0, 0, it) GLB(rb1, 1, it) GLB(rb2, 2, it) GLB(rb3, 3, it)               \
  }
#define GLOAD1(it)                                                                \
  {                                                                               \
    GLA(qa0, 0, it) GLA(qa1, 1, it) GLA(qa2, 2, it) GLA(qa3, 3, it)               \
    GLA(qa4, 4, it) GLA(qa5, 5, it) GLA(qa6, 6, it) GLA(qa7, 7, it)               \
    GLB(qb0, 0, it) GLB(qb1, 1, it) GLB(qb2, 2, it) GLB(qb3, 3, it)               \
  }
#define SSA(ra, c, buf) { *(uint4*)(sA + (buf) * 256 * LDT + (lrow + 32 * (c)) * LDT + lch * 8) = ra; }
#define SSB(rb, c, buf) { *(uint4*)(sB + (buf) * 128 * LDT + (lrow + 32 * (c)) * LDT + lch * 8) = rb; }
#define SSTORE0(buf)                                                              \
  {                                                                               \
    SSA(ra0, 0, buf) SSA(ra1, 1, buf) SSA(ra2, 2, buf) SSA(ra3, 3, buf)           \
    SSA(ra4, 4, buf) SSA(ra5, 5, buf) SSA(ra6, 6, buf) SSA(ra7, 7, buf)           \
    SSB(rb0, 0, buf) SSB(rb1, 1, buf) SSB(rb2, 2, buf) SSB(rb3, 3, buf)           \
  }
#define SSTORE1(buf)                                                              \
  {                                                                               \
    SSA(qa0, 0, buf) SSA(qa1, 1, buf) SSA(qa2, 2, buf) SSA(qa3, 3, buf)           \
    SSA(qa4, 4, buf) SSA(qa5, 5, buf) SSA(qa6, 6, buf) SSA(qa7, 7, buf)           \
    SSB(qb0, 0, buf) SSB(qb1, 1, buf) SSB(qb2, 2, buf) SSB(qb3, 3, buf)           \
  }
#define COMPUTE(buf, LP0, LP1, LP2, LP3)                                                                     \
  {                                                                                                          \
    const bf16_t* a_base = sA + (buf) * 256 * LDT + (wm * 128 + r) * LDT + 8 * lh;                           \
    const bf16_t* b_base = sB + (buf) * 128 * LDT + (wn * 64 + r) * LDT + 8 * lh;                            \
    __builtin_amdgcn_s_setprio(1);                                                                           \
    _Pragma("unroll") for (int s = 0; s < 4; ++s) {                                                          \
      bf16x8 fa[4], fb[2];                                                                                   \
      _Pragma("unroll") for (int q = 0; q < 4; ++q) fa[q] = *(const bf16x8*)(a_base + q * 32 * LDT + s * 16); \
      _Pragma("unroll") for (int q = 0; q < 2; ++q) fb[q] = *(const bf16x8*)(b_base + q * 32 * LDT + s * 16); \
      if (s == 0) { LP0 } else if (s == 1) { LP1 } else if (s == 2) { LP2 } else { LP3 }                     \
      _Pragma("unroll") for (int mi = 0; mi < 4; ++mi)                                                       \
          _Pragma("unroll") for (int ni = 0; ni < 2; ++ni)                                                   \
              acc[mi][ni] = MFMA32(fa[mi], fb[ni], acc[mi][ni]);                                             \
      __builtin_amdgcn_sched_barrier(0);                                                                     \
    }                                                                                                        \
    __builtin_amdgcn_s_setprio(0);                                                                           \
  }
  GLOAD0(0);
  SSTORE0(0);
  __syncthreads();
  const int klast = kiters - 1;
#pragma unroll 1
  for (int it = 0; it < kiters; ++it) {
    const int i1 = (it + 1 < kiters) ? it + 1 : klast;
    COMPUTE(0, GLA(ra0, 0, i1) GLA(ra1, 1, i1) GLA(ra2, 2, i1), GLA(ra3, 3, i1) GLA(ra4, 4, i1) GLA(ra5, 5, i1),
            GLA(ra6, 6, i1) GLA(ra7, 7, i1) GLB(rb0, 0, i1), GLB(rb1, 1, i1) GLB(rb2, 2, i1) GLB(rb3, 3, i1));
    __syncthreads();
    SSTORE0(0);
    __syncthreads();
  }
#undef GLA
#undef GLB
#undef GLOAD0
#undef GLOAD1
#undef SSA
#undef SSB
#undef SSTORE0
#undef SSTORE1
#undef COMPUTE
}

struct ARowMajor {
  const bf16_t* A; int lda; int m0;
  DI const bf16_t* operator()(int row, int it) const { return A + (size_t)(m0 + row) * lda + it * 64; }
};

DI void store_rm(const f32x16 (&v)[2][2], bf16_t* dst, int ld, int row0, int col0, int r, int lh) {
#pragma unroll
  for (int mi = 0; mi < 2; ++mi)
#pragma unroll
    for (int ni = 0; ni < 2; ++ni)
#pragma unroll
      for (int i = 0; i < 16; ++i) dst[(size_t)(row0 + mi * 32 + crow(i, lh)) * ld + col0 + ni * 32 + r] = f2bf(v[mi][ni][i]);
}
DI void store_T(const f32x16 (&v)[2][2], bf16_t* dstT, int t0, int r, int lh) {
#pragma unroll
  for (int mi = 0; mi < 2; ++mi)
#pragma unroll
    for (int ni = 0; ni < 2; ++ni)
#pragma unroll
      for (int g = 0; g < 4; ++g) {
        uint2 u;
        u.x = pack2(v[mi][ni][4 * g], v[mi][ni][4 * g + 1]);
        u.y = pack2(v[mi][ni][4 * g + 2], v[mi][ni][4 * g + 3]);
        *(uint2*)(dstT + (size_t)(ni * 32 + r) * SEQ + t0 + mi * 32 + 8 * g + 4 * lh) = u;
      }
}
DI void rope_tile(f32x16 (&v)[2][2], const float2* tab, int row0, int r, int lh, float scale) {
#pragma unroll
  for (int mi = 0; mi < 2; ++mi)
#pragma unroll
    for (int i = 0; i < 16; ++i) {
      float2 cs = tab[(size_t)(row0 + mi * 32 + crow(i, lh)) * 32 + r];
      float x1 = v[mi][0][i], x2 = v[mi][1][i];
      v[mi][0][i] = (x1 * cs.x - x2 * cs.y) * scale;
      v[mi][1][i] = (x2 * cs.x + x1 * cs.y) * scale;
    }
}

constexpr int LDS_RM = 72;
constexpr int LDS_T = 136;
DI void stage_rm(const f32x16 (&v)[4][2], bf16_t* st, int r, int lh) {
#pragma unroll
  for (int mi = 0; mi < 4; ++mi)
#pragma unroll
    for (int ni = 0; ni < 2; ++ni)
#pragma unroll
      for (int i = 0; i < 16; ++i) st[(mi * 32 + crow(i, lh)) * LDS_RM + ni * 32 + r] = f2bf(v[mi][ni][i]);
}
DI void flush_rm(const bf16_t* st, bf16_t* dst, int ld, int lane) {
  const int rr = lane >> 3, ch = lane & 7;
#pragma unroll 4
  for (int k = 0; k < 16; ++k) {
    const int row = k * 8 + rr;
    *(uint4*)(dst + (size_t)row * ld + ch * 8) = *(const uint4*)(st + row * LDS_RM + ch * 8);
  }
}
DI void stage_T(const f32x16 (&v)[4][2], bf16_t* st, int r, int lh) {
#pragma unroll
  for (int mi = 0; mi < 4; ++mi)
#pragma unroll
    for (int ni = 0; ni < 2; ++ni)
#pragma unroll
      for (int g = 0; g < 4; ++g) {
        uint2 u;
        u.x = pack2(v[mi][ni][4 * g], v[mi][ni][4 * g + 1]);
        u.y = pack2(v[mi][ni][4 * g + 2], v[mi][ni][4 * g + 3]);
        *(uint2*)(st + (ni * 32 + r) * LDS_T + mi * 32 + 8 * g + 4 * lh) = u;
      }
}
DI void flush_T(const bf16_t* st, bf16_t* dstT, int lane) {
  const int dd = lane >> 4, ch = lane & 15;
#pragma unroll 4
  for (int k = 0; k < 16; ++k) {
    const int d = k * 4 + dd;
    *(uint4*)(dstT + (size_t)d * SEQ + ch * 8) = *(const uint4*)(st + d * LDS_T + ch * 8);
  }
}
DI void rope_tile4(f32x16 (&v)[4][2], const float2* tab, int row0, int r, int lh, float scale) {
#pragma unroll
  for (int mi = 0; mi < 4; ++mi) {
#pragma unroll
    for (int i = 0; i < 16; ++i) {
      float2 cs = tab[(size_t)(row0 + mi * 32 + crow(i, lh)) * 32 + r];
      float x1 = v[mi][0][i], x2 = v[mi][1][i];
      v[mi][0][i] = (x1 * cs.x - x2 * cs.y) * scale;
      v[mi][1][i] = (x2 * cs.x + x1 * cs.y) * scale;
    }
    __builtin_amdgcn_sched_barrier(0);
  }
}
DI float ret_l2g(int hd) { return log2f(1.f - exp2f(-(float)(5 + hd))); }

DI void conv_tile(const float* src, int N, bf16_t* dst, int ldd, int k0, int n0, int mode, float* st) {
  const int tid = tid_();
#pragma unroll
  for (int c = 0; c < 8; ++c) {
    const int idx = tid + 256 * c, kk = idx >> 5, n2 = idx & 31, n = n0 + 2 * n2;
    float2 v = make_float2(0.f, 0.f);
    if (n < N) v = *(const float2*)(src + (size_t)(k0 + kk) * N + n);
    st[kk * 65 + 2 * n2] = v.x;
    st[kk * 65 + 2 * n2 + 1] = v.y;
  }
  __syncthreads();
#pragma unroll
  for (int c = 0; c < 4; ++c) {
    const int idx = tid + 256 * c, nn = idx >> 4, k4 = idx & 15, n = n0 + nn;
    const int drow = (mode == 0) ? n : (64 * (n >> 5) + (mode == 2 ? 32 : 0) + (n & 31));
    uint2 u;
    u.x = pack2(st[(4 * k4) * 65 + nn], st[(4 * k4 + 1) * 65 + nn]);
    u.y = pack2(st[(4 * k4 + 2) * 65 + nn], st[(4 * k4 + 3) * 65 + nn]);
    *(uint2*)(dst + (size_t)drow * ldd + k0 + 4 * k4) = u;
  }
  __syncthreads();
}

DI void phase_prep(const Params& p, unsigned char* smem) {
  float* st = (float*)smem;
  const int tid = tid_();
  constexpr int PER = 3268;
  for (int idx = blockIdx.x; idx < 2 * PER; idx += gridDim.x) {
    int L = idx / PER, j = idx % PER;
    if (j < 768) { conv_tile(p.w_in + (size_t)L * DM * NIN, NIN, p.winT() + (size_t)L * NINP * DM, DM, (j / 48) * 64, (j % 48) * 64, 0, st); continue; }
    j -= 768;
    if (j < 256) { conv_tile(p.w_out + (size_t)L * DM * DM, DM, p.woutT() + (size_t)L * DM * DM, DM, (j / 16) * 64, (j % 16) * 64, 0, st); continue; }
    j -= 256;
    if (j < 704) { conv_tile(p.wg + (size_t)L * DM * DFF, DFF, p.wguT() + (size_t)L * 2 * DFF * DM, DM, (j / 44) * 64, (j % 44) * 64, 1, st); continue; }
    j -= 704;
    if (j < 704) { conv_tile(p.wu + (size_t)L * DM * DFF, DFF, p.wguT() + (size_t)L * 2 * DFF * DM, DM, (j / 44) * 64, (j % 44) * 64, 2, st); continue; }
    j -= 704;
    if (j < 704) { conv_tile(p.wd + (size_t)L * DFF * DM, DM, p.wdT() + (size_t)L * DM * DFF, DFF, (j / 16) * 64, (j % 16) * 64, 0, st); continue; }
    j -= 704;
    if (j < 64) { conv_tile(p.cw1_k + (size_t)L * 2048 * 128, 128, p.w1T() + (size_t)(L * 2 + 0) * 128 * 2048, 2048, (j / 2) * 64, (j % 2) * 64, 0, st); continue; }
    j -= 64;
    if (j < 64) { conv_tile(p.cw1_v + (size_t)L * 2048 * 128, 128, p.w1T() + (size_t)(L * 2 + 1) * 128 * 2048, 2048, (j / 2) * 64, (j % 2) * 64, 0, st); continue; }
    j -= 64;
    if (j < 2) { conv_tile(p.cw2_k + (size_t)L * 128 * 64, 64, p.w2T() + (size_t)(L * 2 + 0) * 64 * 128, 128, j * 64, 0, 0, st); continue; }
    j -= 2;
    conv_tile(p.cw2_v + (size_t)L * 128 * 64, 64, p.w2T() + (size_t)(L * 2 + 1) * 64 * 128, 128, j * 64, 0, 0, st);
  }
  for (int idx = blockIdx.x; idx < 8; idx += gridDim.x)
    conv_tile(p.pool_w + (size_t)idx * 4096, 64, p.pwT() + (size_t)idx * 4096, 64, 0, 0, 0, st);
  const size_t gtid = (size_t)blockIdx.x * 256 + tid, gstride = (size_t)gridDim.x * 256;
  for (size_t i = gtid; i < (size_t)MTOK * DM / 4; i += gstride) {
    float4 v = ((const float4*)p.x)[i];
    uint2 u; u.x = pack2(v.x, v.y); u.y = pack2(v.z, v.w);
    ((uint2*)p.xb())[i] = u;
  }
  for (size_t i = gtid; i < (size_t)MTOK * 32; i += gstride) {
    int tok = (int)(i >> 5), k = (int)(i & 31);
    float inv = exp2f(-(float)k * 0.41524101186092029f);
    float ang = (float)p.pos[tok] * inv;
    float kk = rintf(ang * 0.15915494309189535f);
    float rr = fmaf(-kk, 6.2831854820251465f, ang);
    rr = fmaf(-kk, -1.7484556000744883e-07f, rr);
    p.tab()[i] = make_float2(__cosf(rr), __sinf(rr));
  }
  for (int blk = blockIdx.x; blk < 256; blk += gridDim.x) {
    if (tid < 128) {
      const int lw = blk >> 6, kb = blk & 63, L = lw >> 1, which = lw & 1;
      const float* pe = (which ? p.cpos_v : p.cpos_k) + (size_t)L * 2048 + kb * 32;
      const float* w1 = (which ? p.cw1_v : p.cw1_k) + (size_t)L * 2048 * 128 + (size_t)kb * 32 * 128;
      float s = 0.f;
#pragma unroll 8
      for (int k = 0; k < 32; ++k) s = fmaf(pe[k], w1[(size_t)k * 128 + tid], s);
      p.c1()[(size_t)(lw * 64 + kb) * 128 + tid] = s;
    }
  }
}

DI void epi_inproj(f32x16 (&acc)[4][2], int m0, int n0, const Params& p, unsigned char* smem) {
  const int tid = tid_(), lane = tid & 63, w = tid >> 6, wm = w >> 1, wn = w & 1, r = lane & 31, lh = lane >> 5;
  const int cw = n0 + wn * 64;
  const int row0 = m0 + wm * 128;
  const int b = row0 >> 12, t0 = row0 & 4095;
  bf16_t* st = (bf16_t*)(smem + w * 18432);
  bf16_t* rm_dst = nullptr; int rm_ld = 0; bf16_t* t_dst = nullptr; int mode = 0;
  if (cw < 256) { rm_dst = p.vpool() + (size_t)row0 * 256 + cw; rm_ld = 256; }
  else if (cw < 640) { rm_dst = p.qret() + (size_t)row0 * 384 + (cw - 256); rm_ld = 384; mode = 1; }
  else if (cw < 1024) { rm_dst = p.kret() + (size_t)row0 * 384 + (cw - 640); rm_ld = 384; mode = 4; t_dst = p.kzT() + (size_t)((b * 6 + ((cw - 640) >> 6)) * 64) * SEQ + t0; }
  else if (cw < 1408) { t_dst = p.vrT() + (size_t)((b * 6 + ((cw - 1024) >> 6)) * 64) * SEQ + t0; }
  else if (cw < 1792) { rm_dst = p.gret() + (size_t)row0 * 384 + (cw - 1408); rm_ld = 384; mode = 3; }
  else if (cw < 2176) { rm_dst = p.qnsa() + (size_t)row0 * 384 + (cw - 1792); rm_ld = 384; mode = 2; }
  else if (cw < 2304) { rm_dst = p.kcmp() + (size_t)row0 * 128 + (cw - 2176); rm_ld = 128; }
  else if (cw < 2432) { rm_dst = p.vcmp() + (size_t)row0 * 128 + (cw - 2304); rm_ld = 128; }
  else if (cw < 2560) { rm_dst = p.kslc() + (size_t)row0 * 128 + (cw - 2432); rm_ld = 128; mode = 1; }
  else if (cw < 2688) { t_dst = p.vslT() + (size_t)((b * 2 + ((cw - 2560) >> 6)) * 64) * SEQ + t0; }
  else if (cw < 2816) { rm_dst = p.kwin() + (size_t)row0 * 128 + (cw - 2688); rm_ld = 128; mode = 1; }
  else if (cw < 2944) { t_dst = p.vwT() + (size_t)((b * 2 + ((cw - 2816) >> 6)) * 64) * SEQ + t0; }
  else if (cw == 2944) {
    if (r < 18) {
#pragma unroll
      for (int mi = 0; mi < 4; ++mi)
#pragma unroll
        for (int i = 0; i < 16; ++i) p.gates()[(size_t)(row0 + mi * 32 + crow(i, lh)) * 18 + r] = sigmoidf_(acc[mi][0][i]);
    }
  }
  if (mode == 1 || mode == 2 || mode == 4) rope_tile4(acc, p.tab(), row0, r, lh, mode == 1 ? 1.f : (mode == 2 ? 0.125f * LOG2E : 0.125f));
  if (mode == 3) {
#pragma unroll
    for (int mi = 0; mi < 4; ++mi)
#pragma unroll
      for (int ni = 0; ni < 2; ++ni)
#pragma unroll
        for (int i = 0; i < 16; ++i) { float g = acc[mi][ni][i]; acc[mi][ni][i] = g * sigmoidf_(g); }
  }
  if (rm_dst) stage_rm(acc, st, r, lh);
  __syncthreads();
  if (rm_dst) flush_rm(st, rm_dst, rm_ld, lane);
  __syncthreads();
  if (t_dst) {
    if (mode == 4) {
      const float l2g = ret_l2g((cw - 640) >> 6);
#pragma unroll
      for (int mi = 0; mi < 4; ++mi)
#pragma unroll
        for (int i = 0; i < 16; ++i) {
          int tl = (t0 + mi * 32 + crow(i, lh)) & 127;
          float zt = __builtin_amdgcn_exp2f((float)(127 - tl) * l2g);
          acc[mi][0][i] *= zt; acc[mi][1][i] *= zt;
        }
    }
    stage_T(acc, st, r, lh);
  }
  __syncthreads();
  if (t_dst) flush_T(st, t_dst, lane);
}

DI void phase_inproj(const Params& p, int L, int* ctr, int* s_item, unsigned char* smem) {
  const bf16_t* Bt = p.winT() + (size_t)L * NINP * DM;
  for (;;) {
    int mt, nt;
    if (!xcd_tile(ctr, s_item, 128, 24, mt, nt)) break;
    f32x16 acc[4][2];
    ARowMajor af{p.xb(), DM, mt * 256};
    gemm_big(acc, af, Bt, DM, nt * 128, 16, smem, (PROBE_DRY && ctr >= p.ctr() + 512) ? PROBE_DM : 0);
    if (!(PROBE_DRY && ctr >= p.ctr() + 512)) epi_inproj(acc, mt * 256, nt * 128, p, smem);
  }
}

DI f32x16 qk_block(const bf16_t* sK, int ldk, int kb, const bf16x8 (&qf)[4], int r, int lh, float cinit = 0.f) {
  f32x16 s;
#pragma unroll
  for (int i = 0; i < 16; ++i) s[i] = cinit;
  const bf16_t* kp = sK + (kb * 32 + r) * ldk + 8 * lh;
#pragma unroll
  for (int s4 = 0; s4 < 4; ++s4) {
    bf16x8 a = *(const bf16x8*)(kp + 16 * s4);
    s = MFMA32(a, qf[s4], s);
  }
  return s;
}
DI void pv_block(f32x16 (&o)[2], const bf16_t* sVT, int ldv, int kb, const f32x16& pm, int r, int lh) {
#pragma unroll
  for (int sp = 0; sp < 2; ++sp) {
    uint4 pk;
    pk.x = pack2(pm[8 * sp + 0], pm[8 * sp + 1]);
    pk.y = pack2(pm[8 * sp + 2], pm[8 * sp + 3]);
    pk.z = pack2(pm[8 * sp + 4], pm[8 * sp + 5]);
    pk.w = pack2(pm[8 * sp + 6], pm[8 * sp + 7]);
    bf16x8 pb = __builtin_bit_cast(bf16x8, pk);
#pragma unroll
    for (int db = 0; db < 2; ++db) {
      const bf16_t* vp = sVT + (db * 32 + r) * ldv + kb * 32 + 16 * sp + 4 * lh;
      uint2 lo = *(const uint2*)vp;
      uint2 hi = *(const uint2*)(vp + 8);
      uint4 av = make_uint4(lo.x, lo.y, hi.x, hi.y);
      o[db] = MFMA32(__builtin_bit_cast(bf16x8, av), pb, o[db]);
    }
  }
}

template <int MODE>
DI void nsa_item(const Params& p, int item, unsigned char* smem, int u_lo = 0, int u_hi = 3) {
  const int tid = tid_(), lane = tid & 63, w = tid >> 6, r = lane & 31, lh = lane >> 5;
  const int tt = 31 - (item >> 4), bg = item & 15, b = bg >> 1, g = bg & 1;
  const int t0 = tt * 128;
  const int tq = t0 + w * 32 + r;
  const unsigned tok = (unsigned)b * SEQ + tq;
  bf16_t* sK = (bf16_t*)smem;
  bf16_t* sV = (bf16_t*)(smem + 2 * 64 * LDT * 2);
  float* impL = (float*)(smem + 4 * 64 * LDT * 2);
  u64* s_sel = (u64*)(smem + 4 * 64 * LDT * 2);

  const bf16_t* Kb; const bf16_t* Vb; int ldkg, ldvg;
  if (MODE == 0) { Kb = p.kwin() + (size_t)b * SEQ * 128 + g * 64; ldkg = 128; Vb = p.vwT() + (size_t)(b * 2 + g) * 64 * SEQ; ldvg = SEQ; }
  else if (MODE == 1) { Kb = p.kc() + (size_t)(b * 2 + g) * 256 * 64; ldkg = 64; Vb = p.vcT() + (size_t)(b * 2 + g) * 64 * 256; ldvg = 256; }
  else { Kb = p.kslc() + (size_t)b * SEQ * 128 + g * 64; ldkg = 128; Vb = p.vslT() + (size_t)(b * 2 + g) * 64 * SEQ; ldvg = SEQ; }

  u64 mysel = 0, umask = 0;
  int ntiles, kfirst;
  if (MODE == 0) { int klo = t0 - 512; if (klo < 0) klo = 0; kfirst = klo; ntiles = (t0 + 64 - klo) / 64 + 1; }
  else if (MODE == 1) {
    kfirst = 0; int nmax = (t0 + 96) >> 4; ntiles = nmax / 64 + 1; if (ntiles > 4) ntiles = 4;
    for (int i = tid; i < 128 * 65; i += 256) impL[i] = 0.f;
  } else {
    if (tid == 0) s_sel[128] = 0ull;
    __syncthreads();
    if (tid < 128) { u64 sv = p.sel()[(size_t)(b * 2 + g) * SEQ + t0 + tid]; s_sel[tid] = sv; atomicOr(&s_sel[128], sv); }
    __syncthreads();
    mysel = s_sel[w * 32 + r];
    umask = s_sel[128];
    const int jmax = (t0 + 127) >> 6;
    umask &= (jmax >= 63) ? ~0ull : ((1ull << (jmax + 1)) - 1ull);
    umask |= 1ull;
    ntiles = __popcll(umask);
    kfirst = 0;
  }

  constexpr int TP = (MODE == 1) ? 1 : 2;
  const int lrow = tid >> 3, lch = tid & 7;
  const bf16_t* kg0 = Kb + (size_t)lrow * ldkg + lch * 8;
  const bf16_t* kg1 = Kb + (size_t)(lrow + 32) * ldkg + lch * 8;
  const bf16_t* vg0 = Vb + (size_t)lrow * ldvg + lch * 8;
  const bf16_t* vg1 = Vb + (size_t)(lrow + 32) * ldvg + lch * 8;
  const int so0 = lrow * LDT + lch * 8, so1 = (lrow + 32) * LDT + lch * 8;
  uint4 rk0, rk1, rv0, rv1, rk2, rk3, rv2, rv3;
#define KV_GLOAD(keyA, keyB)                                   \
  {                                                            \
    rk0 = *(const uint4*)(kg0 + (size_t)(keyA) * ldkg);        \
    rk1 = *(const uint4*)(kg1 + (size_t)(keyA) * ldkg);        \
    rv0 = *(const uint4*)(vg0 + (keyA));                       \
    rv1 = *(const uint4*)(vg1 + (keyA));                       \
    if (TP == 2) {                                             \
      rk2 = *(const uint4*)(kg0 + (size_t)(keyB) * ldkg);      \
      rk3 = *(const uint4*)(kg1 + (size_t)(keyB) * ldkg);      \
      rv2 = *(const uint4*)(vg0 + (keyB));                     \
      rv3 = *(const uint4*)(vg1 + (keyB));                     \
    }                                                          \
  }
#define KV_SSTORE(stg)                                                     \
  {                                                                        \
    bf16_t* bK_ = sKV + ((stg) * TP) * 2 * 64 * LDT;                       \
    *(uint4*)(bK_ + so0) = rk0;                                            \
    *(uint4*)(bK_ + so1) = rk1;                                            \
    *(uint4*)(bK_ + 64 * LDT + so0) = rv0;                                 \
    *(uint4*)(bK_ + 64 * LDT + so1) = rv1;                                 \
    if (TP == 2) {                                                         \
      *(uint4*)(bK_ + 2 * 64 * LDT + so0) = rk2;                           \
      *(uint4*)(bK_ + 2 * 64 * LDT + so1) = rk3;                           \
      *(uint4*)(bK_ + 3 * 64 * LDT + so0) = rv2;                           \
      *(uint4*)(bK_ + 3 * 64 * LDT + so1) = rv3;                           \
    }                                                                      \
  }
  bf16_t* sKV = (bf16_t*)smem;

#pragma unroll 1
  for (int u = u_lo; u < u_hi; ++u) {
    const int hcol = (g * 3 + u) * 64;
    bf16x8 qf[4];
#pragma unroll
    for (int s = 0; s < 4; ++s) qf[s] = *(const bf16x8*)(p.qnsa() + (size_t)tok * 384 + hcol + 16 * s + 8 * lh);
    f32x16 o[2];
#pragma unroll
    for (int db = 0; db < 2; ++db)
#pragma unroll
      for (int i = 0; i < 16; ++i) o[db][i] = 0.f;
    float m = -1e30f, l = 0.f, invl = 0.f, carry = 0.f;

    const int npass = (MODE == 1) ? 2 : 1;
#pragma unroll 1
    for (int pass = 0; pass < npass; ++pass) {
      u64 rem = umask;
      int ka = kfirst, kb2 = kfirst + 64;
      bool vb = (TP == 2) && (ntiles > 1);
      if (MODE == 2) {
        rem &= rem - 1;
        vb = rem != 0ull;
        kb2 = vb ? (__builtin_ctzll(rem) << 6) : ka;
        rem &= rem - 1;
      }
      const int npairs = (ntiles + TP - 1) / TP;
      KV_GLOAD(ka, kb2);
      KV_SSTORE(0);
      __syncthreads();
#pragma unroll 1
      for (int ti = 0; ti < npairs; ++ti) {
        int na = (TP == 2 ? kb2 : ka) + 64, nb = na + 64;
        bool nvb = (TP == 2) && ((ti + 1) * 2 + 1 < ntiles);
        if (MODE == 2) {
          na = rem ? (__builtin_ctzll(rem) << 6) : 0; rem &= rem - 1;
          nvb = rem != 0ull;
          nb = nvb ? (__builtin_ctzll(rem) << 6) : na;
          rem &= rem - 1;
        }
        if (MODE == 0 && !nvb) nb = na;
        const bool more = ti + 1 < npairs;
        if (more) KV_GLOAD(na, nb);
#pragma unroll 1
        for (int half = 0; half < TP; ++half) {
        if (half == 1 && !vb) break;
        const int key_cur = half ? kb2 : ka;
        const bf16_t* cK = sKV + (((ti & 1) * TP + half) * 2) * 64 * LDT;
        const bf16_t* cV = cK + 64 * LDT;
        int lo, hi;
        if (MODE == 0) { hi = tq - key_cur; lo = tq - 511 - key_cur; }
        else if (MODE == 1) { hi = ((tq - 31) >> 4) - key_cur; lo = 0; }
        else { const int j = key_cur >> 6; hi = ((mysel >> j) & 1ull) ? (tq - key_cur) : -1; lo = 0; }
        const bool skip = (MODE != 1) && __all((hi < 0) || (lo > 63));
        const bool full = __all((lo <= 0) && (hi >= 63));
        const bool rowvalid = hi >= 0;
        const bool rowonly = !full && __all((hi < 0) || ((lo <= 0) && (hi >= 63)));
        if (!skip) {
          const int lo2 = lo - 4 * lh, hi2 = hi - 4 * lh;
          f32x16 S[2];
          bool fastdone = false;
          if (MODE != 1 && (full || rowonly) && __all(!rowvalid || m > -1e29f)) {
            const float cinit = rowvalid ? -m : -1e30f;
            S[0] = qk_block(cK, LDT, 0, qf, r, lh, cinit);
            S[1] = qk_block(cK, LDT, 1, qf, r, lh, cinit);
            float mxs = -1e30f;
#pragma unroll
            for (int kb = 0; kb < 2; ++kb)
#pragma unroll
              for (int i = 0; i < 16; ++i) mxs = fmaxf(mxs, S[kb][i]);
            if (__all(mxs <= 8.f)) {
              float rs = 0.f;
#pragma unroll
              for (int kb = 0; kb < 2; ++kb)
#pragma unroll
                for (int i = 0; i < 16; ++i) {
                  float pv = __builtin_amdgcn_exp2f(S[kb][i]);
                  S[kb][i] = pv;
                  rs += pv;
                }
              l += rs;
              pv_block(o, cV, LDT, 0, S[0], r, lh);
              pv_block(o, cV, LDT, 1, S[1], r, lh);
              fastdone = true;
            }
          }
          if (!fastdone) {
          S[0] = qk_block(cK, LDT, 0, qf, r, lh);
          S[1] = qk_block(cK, LDT, 1, qf, r, lh);
          if (!full && !rowonly) {
            asm volatile("" ::: "memory");
#pragma unroll
            for (int kb = 0; kb < 2; ++kb)
#pragma unroll
              for (int i = 0; i < 16; ++i) {
                const int c = kb * 32 + (i & 3) + 8 * (i >> 2);
                S[kb][i] = (c >= lo2 && c <= hi2) ? S[kb][i] : -1e30f;
              }
          }
          float mx = -1e30f;
#pragma unroll
          for (int kb = 0; kb < 2; ++kb)
#pragma unroll
            for (int i = 0; i < 16; ++i) mx = fmaxf(mx, S[kb][i]);
          if (rowonly) mx = rowvalid ? mx : -1e30f;
          if (MODE == 1 && pass == 1) {
            float mref = fmaxf(m, -1e20f);
            if (rowonly) mref = rowvalid ? mref : 1e30f;
#pragma unroll
            for (int kb = 0; kb < 2; ++kb)
#pragma unroll
              for (int i = 0; i < 16; ++i) S[kb][i] = __builtin_amdgcn_exp2f(S[kb][i] - mref) * invl;
#pragma unroll
            for (int kb = 0; kb < 2; ++kb)
#pragma unroll
              for (int gq = 0; gq < 4; ++gq) {
                float a = 2.f * (S[kb][4 * gq] + S[kb][4 * gq + 1] + S[kb][4 * gq + 2]) + S[kb][4 * gq + 3];
                float bq = S[kb][4 * gq + 3];
                float recv = xor32(bq);
                float tot;
                if (lh == 1) tot = a + recv;
                else { tot = a + carry; carry = recv; }
                const int j = (key_cur >> 2) + 8 * kb + 2 * gq + lh;
                impL[(w * 32 + r) * 65 + j] += tot;
              }
          } else {
            mx = fmaxf(mx, xor32(mx));
            const float mnew = fmaxf(m, mx);
            const float alpha = __builtin_amdgcn_exp2f(m - mnew);
            m = mnew;
            float mref = fmaxf(mnew, -1e20f);
            if (rowonly) mref = rowvalid ? mref : 1e30f;
            float rs = 0.f;
#pragma unroll
            for (int kb = 0; kb < 2; ++kb)
#pragma unroll
              for (int i = 0; i < 16; ++i) {
                float pv = __builtin_amdgcn_exp2f(S[kb][i] - mref);
                S[kb][i] = pv;
                rs += pv;
              }
            l = l * alpha + rs;
            if (MODE != 1) {
#pragma unroll
              for (int db = 0; db < 2; ++db)
#pragma unroll
                for (int i = 0; i < 16; ++i) o[db][i] *= alpha;
            }
          }
          if (!(MODE == 1 && pass == 0)) {
            pv_block(o, cV, LDT, 0, S[0], r, lh);
            pv_block(o, cV, LDT, 1, S[1], r, lh);
          }
          }
        }
        }
        if (more) KV_SSTORE((ti + 1) & 1);
        __syncthreads();
        ka = na; kb2 = nb; vb = nvb;
      }
      if (MODE == 1 && pass == 0) {
        float lt = l + xor32(l);
        invl = lt > 0.f ? 1.f / lt : 0.f;
      }
    }

    if (MODE == 1) {
      if (lh == 0) impL[(w * 32 + r) * 65 + 16 * ntiles] += carry;
#pragma unroll
      for (int db = 0; db < 2; ++db)
#pragma unroll
        for (int gq = 0; gq < 4; ++gq) {
          uint2 uu;
          uu.x = pack2(o[db][4 * gq], o[db][4 * gq + 1]);
          uu.y = pack2(o[db][4 * gq + 2], o[db][4 * gq + 3]);
          *(uint2*)(p.ocmp() + (size_t)tok * 384 + hcol + db * 32 + 8 * gq + 4 * lh) = uu;
        }
    } else {
      float lt = l + xor32(l);
      const float il = lt > 0.f ? 1.f / lt : 0.f;
      float g0 = 0.f, g1 = 0.f, g2 = 0.f;
      if (MODE == 2) {
        const float* gp = p.gates() + (size_t)tok * 18 + (g * 3 + u) * 3;
        g0 = gp[0]; g1 = gp[1]; g2 = gp[2];
      }
#pragma unroll
      for (int db = 0; db < 2; ++db)
#pragma unroll
        for (int gq = 0; gq < 4; ++gq) {
          const int d0 = db * 32 + 8 * gq + 4 * lh;
          float v0 = o[db][4 * gq] * il, v1 = o[db][4 * gq + 1] * il, v2 = o[db][4 * gq + 2] * il, v3 = o[db][4 * gq + 3] * il;
          bf16_t* yp = (MODE == 0) ? (p.owin() + (size_t)tok * 384 + hcol + d0) : (p.y() + (size_t)tok * DM + 640 + hcol + d0);
          if (MODE == 2) {
            uint2 oc = *(const uint2*)(p.ocmp() + (size_t)tok * 384 + hcol + d0);
            uint2 ow = *(const uint2*)(p.owin() + (size_t)tok * 384 + hcol + d0);
            v0 = g0 * bf2f((bf16_t)(oc.x & 0xffff)) + g1 * v0 + g2 * bf2f((bf16_t)(ow.x & 0xffff));
            v1 = g0 * bf2f((bf16_t)(oc.x >> 16)) + g1 * v1 + g2 * bf2f((bf16_t)(ow.x >> 16));
            v2 = g0 * bf2f((bf16_t)(oc.y & 0xffff)) + g1 * v2 + g2 * bf2f((bf16_t)(ow.y & 0xffff));
            v3 = g0 * bf2f((bf16_t)(oc.y >> 16)) + g1 * v3 + g2 * bf2f((bf16_t)(ow.y >> 16));
          }
          uint2 uu; uu.x = pack2(v0, v1); uu.y = pack2(v2, v3);
          *(uint2*)yp = uu;
        }
    }
  }
#undef KV_GLOAD
#undef KV_SSTORE

  if (MODE == 1) {
    __syncthreads();
#pragma unroll 1
    for (int q = 0; q < 32; ++q) {
      const int row = w * 32 + q;
      const int t = t0 + row;
      const int cur = t >> 6;
      u64 msk;
      if (cur < 16) {
        msk = (1ull << (cur + 1)) - 1ull;
      } else {
        float v = impL[row * 65 + lane];
        float sc = (lane <= cur) ? ((lane == 0 || lane == cur || lane == cur - 1) ? 1e6f : v) : -1.f;
        const unsigned ub = __float_as_uint(sc);
        const unsigned key = (ub & 0x80000000u) ? ~ub : (ub | 0x80000000u);
        unsigned T = 0u;
#pragma unroll 1
        for (int bit = 31; bit >= 0; --bit) {
          const unsigned cand = T | (1u << bit);
          if (__popcll(__ballot(key >= cand)) >= 16) T = cand;
        }
        msk = __ballot(key > T);
        u64 eq = __ballot(key == T);
        int remaining = 16 - __popcll(msk);
        while (remaining > 0 && eq) { msk |= eq & (~eq + 1ull); eq &= eq - 1ull; --remaining; }
      }
      if (lane == 0) p.sel()[(size_t)(b * 2 + g) * SEQ + t] = msk;
    }
  }
}

DI void retkv_item(const Params& p, int item) {
  const int tid = tid_(), lane = tid & 63, w = tid >> 6, r = lane & 31, lh = lane >> 5;
  const int n = item & 31, bh = item >> 5;
  const int eb = w >> 1, db = w & 1;
  f32x16 acc;
#pragma unroll
  for (int i = 0; i < 16; ++i) acc[i] = 0.f;
  const bf16_t* ap = p.vrT() + (size_t)(bh * 64 + eb * 32 + r) * SEQ + n * 128 + 8 * lh;
  const bf16_t* bp = p.kzT() + (size_t)(bh * 64 + db * 32 + r) * SEQ + n * 128 + 8 * lh;
#pragma unroll
  for (int s = 0; s < 8; ++s) {
    bf16x8 a = *(const bf16x8*)(ap + 16 * s);
    bf16x8 bb = *(const bf16x8*)(bp + 16 * s);
    acc = MFMA32(a, bb, acc);
  }
  float* dst = p.kvT() + (size_t)item * 4096;
#pragma unroll
  for (int i = 0; i < 16; ++i) dst[(eb * 32 + crow(i, lh)) * 64 + db * 32 + r] = acc[i];
}

DI void retscan_item(const Params& p, int item) {
  const int bh = item >> 4, part = item & 15, hd = bh % 6;
  const int idx = part * 256 + tid_();
  const float gc = exp2f(128.f * ret_l2g(hd));
  float kv[32];
#pragma unroll
  for (int n = 0; n < 32; ++n) kv[n] = p.kvT()[(size_t)(bh * 32 + n) * 4096 + idx];
  float st = 0.f;
#pragma unroll
  for (int n = 0; n < 32; ++n) {
    p.RT()[(size_t)(bh * 32 + n) * 4096 + idx] = f2bf(st);
    st = fmaf(gc, st, kv[n]);
  }
}

DI void retout_item(const Params& p, int L, int item, unsigned char* smem) {
  const int tid = tid_(), lane = tid & 63, w = tid >> 6, r = lane & 31, lh = lane >> 5;
  const int n = item & 31, bh = item >> 5, hd = bh % 6, b = bh / 6;
  constexpr int LDV2 = 136;
  bf16_t* sK = (bf16_t*)smem;
  bf16_t* sV = (bf16_t*)(smem + 128 * LDT * 2);
  const size_t tok0 = (size_t)b * SEQ + n * 128;
  {
    const int lrow = tid >> 3, lch = tid & 7;
#pragma unroll
    for (int c = 0; c < 4; ++c)
      *(uint4*)(sK + (lrow + 32 * c) * LDT + lch * 8) = *(const uint4*)(p.kret() + (tok0 + lrow + 32 * c) * 384 + hd * 64 + lch * 8);
    const int vrow = tid >> 4, vch = tid & 15;
#pragma unroll
    for (int c = 0; c < 4; ++c)
      *(uint4*)(sV + (vrow + 16 * c) * LDV2 + vch * 8) = *(const uint4*)(p.vrT() + (size_t)(bh * 64 + vrow + 16 * c) * SEQ + n * 128 + vch * 8);
  }
  const int iq = w * 32 + r;
  const size_t tok = tok0 + iq;
  bf16x8 qf[4];
#pragma unroll
  for (int s = 0; s < 4; ++s) qf[s] = *(const bf16x8*)(p.qret() + tok * 384 + hd * 64 + 16 * s + 8 * lh);
  const float l2g = ret_l2g(hd);
  f32x16 o[2];
#pragma unroll
  for (int db = 0; db < 2; ++db)
#pragma unroll
    for (int i = 0; i < 16; ++i) o[db][i] = 0.f;
  const bf16_t* rt = p.RT() + (size_t)item * 4096;
#pragma unroll
  for (int db = 0; db < 2; ++db)
#pragma unroll
    for (int s = 0; s < 4; ++s) {
      bf16x8 a = *(const bf16x8*)(rt + (db * 32 + r) * 64 + 16 * s + 8 * lh);
      o[db] = MFMA32(a, qf[s], o[db]);
    }
  const float xi = exp2f((float)(iq + 1) * l2g);
#pragma unroll
  for (int db = 0; db < 2; ++db)
#pragma unroll
    for (int i = 0; i < 16; ++i) o[db][i] *= xi;
  __syncthreads();
  for (int kb = 0; kb <= w; ++kb) {
    f32x16 S = qk_block(sK, LDT, kb, qf, r, lh);
#pragma unroll
    for (int i = 0; i < 16; ++i) {
      const int diff = iq - (kb * 32 + crow(i, lh));
      S[i] = diff >= 0 ? S[i] * __builtin_amdgcn_exp2f((float)diff * l2g) : 0.f;
    }
    pv_block(o, sV, LDV2, kb, S, r, lh);
  }
  float sm = 0.f;
#pragma unroll
  for (int db = 0; db < 2; ++db)
#pragma unroll
    for (int i = 0; i < 16; ++i) sm += o[db][i];
  sm += xor32(sm);
  const float mu = sm * (1.f / 64.f);
  float vs = 0.f;
#pragma unroll
  for (int db = 0; db < 2; ++db)
#pragma unroll
    for (int i = 0; i < 16; ++i) { float dd = o[db][i] - mu; vs += dd * dd; }
  vs += xor32(vs);
  const float rstd = rsqrtf(vs * (1.f / 64.f) + 1e-5f);
  const float* gng = p.gn_g + (size_t)L * 384 + hd * 64;
#pragma unroll
  for (int db = 0; db < 2; ++db)
#pragma unroll
    for (int gq = 0; gq < 4; ++gq) {
      const int d0 = db * 32 + 8 * gq + 4 * lh;
      uint2 sg = *(const uint2*)(p.gret() + tok * 384 + hd * 64 + d0);
      float4 gg = *(const float4*)(gng + d0);
      float v0 = (o[db][4 * gq] - mu) * rstd * gg.x * bf2f((bf16_t)(sg.x & 0xffff));
      float v1 = (o[db][4 * gq + 1] - mu) * rstd * gg.y * bf2f((bf16_t)(sg.x >> 16));
      float v2 = (o[db][4 * gq + 2] - mu) * rstd * gg.z * bf2f((bf16_t)(sg.y & 0xffff));
      float v3 = (o[db][4 * gq + 3] - mu) * rstd * gg.w * bf2f((bf16_t)(sg.y >> 16));
      uint2 uu; uu.x = pack2(v0, v1); uu.y = pack2(v2, v3);
      *(uint2*)(p.y() + tok * DM + 256 + hd * 64 + d0) = uu;
    }
}

DI void pool_item(const Params& p, int L, int item, unsigned char* smem) {
  const int tid = tid_(), lane = tid & 63, w = tid >> 6, r = lane & 31, lh = lane >> 5;
  const int gi = item & 3, tt = (item >> 2) & 63, b = item >> 8;
  const int t0 = tt * 64;
  float* sv = (float*)smem;
  bf16_t* am = (bf16_t*)(smem + 79 * 65 * 4 + 4);
  for (int idx = tid; idx < 79 * 8; idx += 256) {
    const int rr = idx >> 3, ch = idx & 7, ts = t0 - 15 + rr;
    uint4 u = make_uint4(0, 0, 0, 0);
    if (ts >= 0) u = *(const uint4*)(p.vpool() + ((size_t)b * SEQ + ts) * 256 + gi * 64 + ch * 8);
    float* d = sv + rr * 65 + ch * 8;
    d[0] = bf2f((bf16_t)(u.x & 0xffff)); d[1] = bf2f((bf16_t)(u.x >> 16)); d[2] = bf2f((bf16_t)(u.y & 0xffff)); d[3] = bf2f((bf16_t)(u.y >> 16));
    d[4] = bf2f((bf16_t)(u.z & 0xffff)); d[5] = bf2f((bf16_t)(u.z >> 16)); d[6] = bf2f((bf16_t)(u.w & 0xffff)); d[7] = bf2f((bf16_t)(u.w >> 16));
  }
  __syncthreads();
  const int win = 2 << gi;
  for (int idx = tid; idx < 4096; idx += 256) {
    const int tl = idx >> 6, c = idx & 63, t = t0 + tl;
    int lo = t + 1 - win; if (lo < 0) lo = 0;
    float s = 0.f;
    for (int u = lo; u <= t; ++u) s += sv[(u - t0 + 15) * 65 + c];
    am[tl * 72 + c] = f2bf(s / (float)(t + 1 - lo) - sv[(tl + 15) * 65 + c]);
  }
  __syncthreads();
  const int mb = w >> 1, nb = w & 1;
  f32x16 acc;
#pragma unroll
  for (int i = 0; i < 16; ++i) acc[i] = 0.f;
  const bf16_t* bp = p.pwT() + ((size_t)(L * 4 + gi) * 64 + nb * 32 + r) * 64 + 8 * lh;
#pragma unroll
  for (int s = 0; s < 4; ++s) {
    bf16x8 a = *(const bf16x8*)(am + (mb * 32 + r) * 72 + 16 * s + 8 * lh);
    bf16x8 bb = *(const bf16x8*)(bp + 16 * s);
    acc = MFMA32(a, bb, acc);
  }
  const int d = nb * 32 + r;
  const float scl = p.pool_scale[L * 256 + gi * 64 + d];
#pragma unroll
  for (int i = 0; i < 16; ++i)
    p.y()[((size_t)b * SEQ + t0 + mb * 32 + crow(i, lh)) * DM + gi * 64 + d] = f2bf(acc[i] * scl);
}

DI void compress_item(const Params& p, int L, int item, unsigned char* smem) {
  const int tid = tid_(), lane = tid & 63, w = tid >> 6, r = lane & 31, lh = lane >> 5;
  const int which = item >> 7, rest = item & 127, bg = rest >> 3, q = rest & 7, b = bg >> 1, g = bg & 1;
  const int i0 = q * 32;
  constexpr int LDC = 136;
  bf16_t* sA = (bf16_t*)smem;
  bf16_t* sB = (bf16_t*)(smem + 32 * LDC * 2);
  const bf16_t* src = (which ? p.vcmp() : p.kcmp()) + (size_t)b * SEQ * 128 + g * 64;
  const bf16_t* w1 = p.w1T() + (size_t)(L * 2 + which) * 128 * 2048;
  uint4 ra0, ra1, rb0, rb1, rb2, rb3, rb4, rb5, rb6, rb7;
  const int c16 = tid & 15, rowq = tid >> 4;
#define CLA(ra, c, it)                                                                                   \
  {                                                                                                      \
    const int ci = i0 + rowq + 16 * (c);                                                                 \
    const int l = 2 * (it) + (c16 >> 3);                                                                 \
    ra = (ci <= 254) ? *(const uint4*)(src + (size_t)(16 * ci + l) * 128 + (c16 & 7) * 8) : make_uint4(0, 0, 0, 0); \
  }
#define CLB(rb, c, it) { rb = *(const uint4*)(w1 + (size_t)(rowq + 16 * (c)) * 2048 + (it) * 128 + c16 * 8); }
#define CLOAD(it) { CLA(ra0, 0, it) CLA(ra1, 1, it) CLB(rb0, 0, it) CLB(rb1, 1, it) CLB(rb2, 2, it) CLB(rb3, 3, it) CLB(rb4, 4, it) CLB(rb5, 5, it) CLB(rb6, 6, it) CLB(rb7, 7, it) }
#define CSA(ra, c) { *(uint4*)(sA + (rowq + 16 * (c)) * LDC + c16 * 8) = ra; }
#define CSB(rb, c) { *(uint4*)(sB + (rowq + 16 * (c)) * LDC + c16 * 8) = rb; }
#define CSTORE() { CSA(ra0, 0) CSA(ra1, 1) CSB(rb0, 0) CSB(rb1, 1) CSB(rb2, 2) CSB(rb3, 3) CSB(rb4, 4) CSB(rb5, 5) CSB(rb6, 6) CSB(rb7, 7) }
  f32x16 acc;
#pragma unroll
  for (int i = 0; i < 16; ++i) acc[i] = 0.f;
  CLOAD(0);
  CSTORE();
  __syncthreads();
#pragma unroll 1
  for (int it = 0; it < 16; ++it) {
    const int i1 = (it + 1 < 16) ? it + 1 : 15;
    CLOAD(i1);
#pragma unroll
    for (int s = 0; s < 8; ++s) {
      bf16x8 a = *(const bf16x8*)(sA + r * LDC + 16 * s + 8 * lh);
      bf16x8 bb = *(const bf16x8*)(sB + (32 * w + r) * LDC + 16 * s + 8 * lh);
      acc = MFMA32(a, bb, acc);
    }
    __syncthreads();
    CSTORE();
    __syncthreads();
  }
#undef CLA
#undef CLB
#undef CLOAD
#undef CSA
#undef CSB
#undef CSTORE
  bf16_t* Hs = (bf16_t*)smem;
  {
    const int col = 32 * w + r;
    const float* c1 = p.c1() + (size_t)(L * 2 + which) * 64 * 128;
    float cb = ((which ? p.cb1_v : p.cb1_k) + (size_t)L * 128)[col];
    for (int kb = 0; kb < 64; ++kb) cb += c1[kb * 128 + col];
#pragma unroll
    for (int i = 0; i < 16; ++i) Hs[crow(i, lh) * LDC + col] = f2bf(gelu_tanh(acc[i] + cb));
  }
  __syncthreads();
  if (w == 0) {
    f32x16 o[2];
#pragma unroll
    for (int nb = 0; nb < 2; ++nb)
#pragma unroll
      for (int i = 0; i < 16; ++i) o[nb][i] = 0.f;
    const bf16_t* w2 = p.w2T() + (size_t)(L * 2 + which) * 64 * 128;
#pragma unroll
    for (int s = 0; s < 8; ++s) {
      bf16x8 a = *(const bf16x8*)(Hs + r * LDC + 16 * s + 8 * lh);
#pragma unroll
      for (int nb = 0; nb < 2; ++nb) {
        bf16x8 bb = *(const bf16x8*)(w2 + (nb * 32 + r) * 128 + 16 * s + 8 * lh);
        o[nb] = MFMA32(a, bb, o[nb]);
      }
    }
    if (which == 0) {
#pragma unroll
      for (int i = 0; i < 16; ++i) {
        const int ci = i0 + crow(i, lh);
        float v1 = 0.f, v2 = 0.f;
        if (ci <= 254) {
          float2 cs = p.tab()[((size_t)b * SEQ + 16 * ci + 31) * 32 + r];
          float x1 = o[0][i], x2 = o[1][i];
          v1 = x1 * cs.x - x2 * cs.y; v2 = x2 * cs.x + x1 * cs.y;
        }
        p.kc()[((size_t)bg * 256 + ci) * 64 + r] = f2bf(v1);
        p.kc()[((size_t)bg * 256 + ci) * 64 + 32 + r] = f2bf(v2);
      }
    } else {
#pragma unroll
      for (int nb = 0; nb < 2; ++nb)
#pragma unroll
        for (int gq = 0; gq < 4; ++gq) {
          uint2 uu;
          uu.x = pack2(o[nb][4 * gq], o[nb][4 * gq + 1]);
          uu.y = pack2(o[nb][4 * gq + 2], o[nb][4 * gq + 3]);
          *(uint2*)(p.vcT() + ((size_t)bg * 64 + nb * 32 + r) * 256 + i0 + 8 * gq + 4 * lh) = uu;
        }
    }
  }
}

DI void phase_mixA(const Params& p, int L, int* ctr, int* s_item, unsigned char* smem) {
  for (;;) {
    int item = next_item(ctr, s_item);
    if (item >= 256 + 1536 + 1536 + 2048) break;
    if (item < 256) compress_item(p, L, item, smem);
    else if (item < 256 + 1536) { const int q = item - 256, uu = q % 3; nsa_item<0>(p, q / 3, smem, uu, uu + 1); }
    else if (item < 256 + 1536 + 1536) retkv_item(p, item - 256 - 1536);
    else pool_item(p, L, item - 256 - 1536 - 1536, smem);
  }
}
DI void phase_mixB(const Params& p, int L, int* ctr, int* s_item, unsigned char* smem) {
  for (;;) {
    int item = next_item(ctr, s_item);
    if (item >= 512 + 768) break;
    if (item < 512) nsa_item<1>(p, item, smem);
    else retscan_item(p, item - 512);
  }
}
DI void phase_mixC(const Params& p, int L, int* ctr, int* s_item, unsigned char* smem) {
  for (;;) {
    int item = next_item(ctr, s_item);
    if (item >= 1536 + 1536) break;
    if (item < 1536) { const int uu = item % 3; nsa_item<2>(p, item / 3, smem, uu, uu + 1); }
    else retout_item(p, L, item - 1536, smem);
  }
}

DI void epi_resid(const f32x16 (&acc)[4][2], int m0, int n0, const Params& p, int mode, const float2* stats, const float* lg, const float* lb,
                  unsigned char* smem) {
  const int tid = tid_(), lane = tid & 63, w = tid >> 6, wm = w >> 1, wn = w & 1, r = lane & 31, lh = lane >> 5;
  constexpr int LDF = 68;
  float* st = (float*)(smem + w * (64 * LDF * 4));
  const int colbase = n0 + wn * 64;
  const int rr = lane >> 4, ch = lane & 15;
  const float4 gg = *(const float4*)(lg + colbase + ch * 4);
  const float4 bb = *(const float4*)(lb + colbase + ch * 4);
#pragma unroll
  for (int half = 0; half < 2; ++half) {
#pragma unroll
    for (int mh = 0; mh < 2; ++mh)
#pragma unroll
      for (int ni = 0; ni < 2; ++ni)
#pragma unroll
        for (int i = 0; i < 16; ++i) st[(mh * 32 + crow(i, lh)) * LDF + ni * 32 + r] = acc[half * 2 + mh][ni][i];
    __syncthreads();
#pragma unroll 8
    for (int k = 0; k < 16; ++k) {
      const int lrow = k * 4 + rr;
      const size_t row = (size_t)(m0 + wm * 128 + half * 64 + lrow);
      const float4 a = *(const float4*)(st + lrow * LDF + ch * 4);
      float* zp = p.z + row * DM + colbase + ch * 4;
      float4 res;
      if (mode == 0) res = *(const float4*)(p.x + row * DM + colbase + ch * 4);
      else {
        const float2 sv = stats[row];
        const float4 zz = *(const float4*)zp;
        res.x = (zz.x - sv.x) * sv.y * gg.x + bb.x; res.y = (zz.y - sv.x) * sv.y * gg.y + bb.y;
        res.z = (zz.z - sv.x) * sv.y * gg.z + bb.z; res.w = (zz.w - sv.x) * sv.y * gg.w + bb.w;
      }
      *(float4*)zp = make_float4(ALPHA * res.x + a.x, ALPHA * res.y + a.y, ALPHA * res.z + a.z, ALPHA * res.w + a.w);
    }
    __syncthreads();
  }
}

DI void phase_outproj(const Params& p, int L, int* ctr, int* s_item, unsigned char* smem) {
  const bf16_t* Bt = p.woutT() + (size_t)L * DM * DM;
  for (;;) {
    int mt, nt;
    if (!xcd_tile(ctr, s_item, 128, 8, mt, nt)) break;
    f32x16 acc[4][2];
    ARowMajor af{p.y(), DM, mt * 256};
    gemm_big(acc, af, Bt, DM, nt * 128, 16, smem);
    epi_resid(acc, mt * 256, nt * 128, p, L == 0 ? 0 : 1, p.stats2(), p.ln2g + (size_t)(L ? L - 1 : 0) * DM, p.ln2b + (size_t)(L ? L - 1 : 0) * DM, smem);
  }
}

DI void phase_ffn2(const Params& p, int L, int* ctr, int* s_item, unsigned char* smem) {
  const bf16_t* Bt = p.wdT() + (size_t)L * DM * DFF;
  for (;;) {
    int mt, nt;
    if (!xcd_tile(ctr, s_item, 128, 8, mt, nt)) break;
    f32x16 acc[4][2];
    ARowMajor af{p.act(), DFF, mt * 256};
    gemm_big(acc, af, Bt, DFF, nt * 128, 44, smem);
    epi_resid(acc, mt * 256, nt * 128, p, 1, p.stats1(), p.ln1g + (size_t)L * DM, p.ln1b + (size_t)L * DM, smem);
  }
}

struct AFfn1 {
  const bf16_t* xb; int tbase;
  DI const bf16_t* operator()(int row, int it) const {
    int ts = tbase + row;
    ts = ts < 0 ? 0 : (ts >= SEQ ? SEQ - 1 : ts);
    return xb + (size_t)ts * DM + it * 64;
  }
};
DI void phase_ffn1(const Params& p, int L, int* ctr, int* s_item, unsigned char* smem) {
  const bf16_t* Bt = p.wguT() + (size_t)L * 2 * DFF * DM;
  constexpr int LDG = 65;
  float* sg = (float*)smem;
  for (;;) {
    int mt, nt;
    if (!xcd_tile(ctr, s_item, 136, 44, mt, nt)) break;
    const int b = mt / 17, it_ = mt % 17;
    const int tbase = 254 * it_ - 2;
    f32x16 acc[4][2];
    AFfn1 af{p.xb() + (size_t)b * SEQ * DM, tbase};
    gemm_big(acc, af, Bt, DM, nt * 128, 16, smem, (PROBE_DRY && ctr >= p.ctr() + 512) ? PROBE_DM : 0);
    if (PROBE_DRY && ctr >= p.ctr() + 512) { if (acc[0][0][0] == 12345.678f) sg[0] = acc[1][1][3] + acc[2][0][5] + acc[3][1][7]; continue; }
    const int tid = tid_(), lane = tid & 63, w = tid >> 6, wm = w >> 1, wn = w & 1, r = lane & 31, lh = lane >> 5;
    if (tbase < 0 && wm == 0 && lh == 0) { acc[0][0][0] = 0.f; acc[0][0][1] = 0.f; }
#pragma unroll
    for (int mi = 0; mi < 4; ++mi)
#pragma unroll
      for (int i = 0; i < 16; ++i) sg[(wm * 128 + mi * 32 + crow(i, lh)) * LDG + wn * 32 + r] = acc[mi][0][i];
    __syncthreads();
    const float* cw = p.convw + (size_t)L * 3 * DFF;
    const int fl = wn * 32 + r;
    const int f = nt * 64 + fl;
    const float w0 = cw[f], w1 = cw[DFF + f], w2 = cw[2 * DFF + f], cb = p.convb[(size_t)L * DFF + f];
#pragma unroll
    for (int mi = 0; mi < 4; ++mi) {
#pragma unroll
      for (int gq = 0; gq < 4; ++gq) {
        const int rbase = wm * 128 + mi * 32 + 8 * gq + 4 * lh;
        float prev1 = rbase >= 1 ? sg[(rbase - 1) * LDG + fl] : 0.f;
        float prev2 = rbase >= 2 ? sg[(rbase - 2) * LDG + fl] : 0.f;
#pragma unroll
        for (int k = 0; k < 4; ++k) {
          const int rr = rbase + k, ts = tbase + rr;
          const float gv = acc[mi][0][4 * gq + k];
          const float hc = cb + w0 * prev2 + w1 * prev1 + w2 * gv;
          acc[mi][1][4 * gq + k] = gelu_tanh(hc) * acc[mi][1][4 * gq + k];
          prev2 = prev1; prev1 = gv;
        }
        __builtin_amdgcn_sched_barrier(0);
      }
    }
    __syncthreads();
    {
      constexpr int LDO = 40;
      bf16_t* so = (bf16_t*)(smem + w * (128 * LDO * 2));
#pragma unroll
      for (int mi = 0; mi < 4; ++mi)
#pragma unroll
        for (int i = 0; i < 16; ++i) so[(mi * 32 + crow(i, lh)) * LDO + r] = f2bf(acc[mi][1][i]);
      __syncthreads();
      const int lr = lane >> 2, ch = lane & 3;
      bf16_t* dst = p.act() + (size_t)b * SEQ * DFF + nt * 64 + wn * 32 + ch * 8;
#pragma unroll 8
      for (int k = 0; k < 8; ++k) {
        const int row = k * 16 + lr, rr = wm * 128 + row, ts = tbase + rr;
        if (rr >= 2 && ts < SEQ) *(uint4*)(dst + (size_t)ts * DFF) = *(const uint4*)(so + row * LDO + ch * 8);
      }
    }
  }
}

DI void phase_ln(const Params& p, const float* lg, const float* lb, float2* stats, bool final_) {
  const int tid = tid_(), lane = tid & 63, w = tid >> 6;
  for (int row0 = (blockIdx.x * 4 + w) * 2; row0 < MTOK; row0 += gridDim.x * 8) {
    float4 v[2][4];
#pragma unroll
    for (int rr = 0; rr < 2; ++rr)
#pragma unroll
      for (int c = 0; c < 4; ++c) v[rr][c] = *(const float4*)(p.z + (size_t)(row0 + rr) * DM + c * 256 + lane * 4);
#pragma unroll
    for (int rr = 0; rr < 2; ++rr) {
      const int row = row0 + rr;
      float* zr = p.z + (size_t)row * DM;
      float s = 0.f;
#pragma unroll
      for (int c = 0; c < 4; ++c) s += v[rr][c].x + v[rr][c].y + v[rr][c].z + v[rr][c].w;
#pragma unroll
      for (int off = 32; off >= 1; off >>= 1) s += __shfl_xor(s, off);
      const float mu = s * (1.f / 1024.f);
      float q = 0.f;
#pragma unroll
      for (int c = 0; c < 4; ++c) {
        float a = v[rr][c].x - mu, b = v[rr][c].y - mu, cc = v[rr][c].z - mu, d = v[rr][c].w - mu;
        q += a * a + b * b + cc * cc + d * d;
      }
#pragma unroll
      for (int off = 32; off >= 1; off >>= 1) q += __shfl_xor(q, off);
      const float rstd = rsqrtf(q * (1.f / 1024.f) + 1e-5f);
      if (lane == 0) stats[row] = make_float2(mu, rstd);
#pragma unroll
      for (int c = 0; c < 4; ++c) {
        const int col = c * 256 + lane * 4;
        float4 gg = *(const float4*)(lg + col), bb = *(const float4*)(lb + col);
        float o0 = (v[rr][c].x - mu) * rstd * gg.x + bb.x, o1 = (v[rr][c].y - mu) * rstd * gg.y + bb.y;
        float o2 = (v[rr][c].z - mu) * rstd * gg.z + bb.z, o3 = (v[rr][c].w - mu) * rstd * gg.w + bb.w;
        if (final_) *(float4*)(zr + col) = make_float4(o0, o1, o2, o3);
        else { uint2 u; u.x = pack2(o0, o1); u.y = pack2(o2, o3); *(uint2*)(p.xb() + (size_t)row * DM + col) = u; }
      }
    }
  }
}

__global__ void __launch_bounds__(256, 2) mega(Params p_, int ph_lo, int ph_hi) {
  __shared__ __attribute__((aligned(16))) unsigned char smem[73728];
  __shared__ int s_item;
  int rep = 0; int first = 1; int nbar = 0;
  for (int ph = ph_lo; ph < ph_hi; ++ph) {
#if COOP
    if (!first) {
      ++nbar;
      if (ph_hi < 0) cg::this_grid().sync();
      grid_bar((unsigned*)(p_.ctr() + 2048), (unsigned)nbar);
    }
    first = 0;
#endif
    const Params& p = p_;
    int* ctr = p.ctr() + ph * 8;
    if (ph == 0) { phase_prep(p, smem); continue; }
    const int L = (ph - 1) / 9, sub = (ph - 1) % 9;
#ifdef PROBE_MASK
    if (((PROBE_MASK >> sub) & 1) && !((sub == 4 || sub == 8) && L != 0) && sub != 7) {
      if (rep == 0) { --ph; rep = 1; ctr += 512; } else { rep = 0; }
    }
#endif
    switch (sub) {
      case 0: phase_inproj(p, L, ctr, &s_item, smem); break;
      case 1: phase_mixA(p, L, ctr, &s_item, smem); break;
      case 2: phase_mixB(p, L, ctr, &s_item, smem); break;
      case 3: phase_mixC(p, L, ctr, &s_item, smem); break;
      case 4: phase_outproj(p, L, ctr, &s_item, smem); break;
      case 5: phase_ln(p, p.ln1g + (size_t)L * DM, p.ln1b + (size_t)L * DM, p.stats1(), false); break;
      case 6: phase_ffn1(p, L, ctr, &s_item, smem); break;
      case 7: phase_ffn2(p, L, ctr, &s_item, smem); break;
      default: phase_ln(p, p.ln2g + (size_t)L * DM, p.ln2b + (size_t)L * DM, p.stats2(), L == 1); break;
    }
  }
}

extern "C" void kernel_launch(void* const* d_in, const int* in_sizes, int n_in, void* d_out, int out_size, void* d_ws, size_t ws_size,
                              hipStream_t stream) {
  Params p{};
  p.x = (const float*)d_in[0]; p.pos = (const int*)d_in[1]; p.w_in = (const float*)d_in[2]; p.w_out = (const float*)d_in[3];
  p.pool_w = (const float*)d_in[4]; p.pool_scale = (const float*)d_in[5]; p.gn_g = (const float*)d_in[6];
  p.cpos_k = (const float*)d_in[7]; p.cw1_k = (const float*)d_in[8]; p.cb1_k = (const float*)d_in[9]; p.cw2_k = (const float*)d_in[10];
  p.cpos_v = (const float*)d_in[11]; p.cw1_v = (const float*)d_in[12]; p.cb1_v = (const float*)d_in[13]; p.cw2_v = (const float*)d_in[14];
  p.wg = (const float*)d_in[15]; p.wu = (const float*)d_in[16]; p.convw = (const float*)d_in[17]; p.convb = (const float*)d_in[18];
  p.wd = (const float*)d_in[19]; p.ln1g = (const float*)d_in[20]; p.ln1b = (const float*)d_in[21]; p.ln2g = (const float*)d_in[22];
  p.ln2b = (const float*)d_in[23];
  p.z = (float*)d_out;
  p.ws = (unsigned char*)d_ws;
  if (WS_NEED > ws_size) { fprintf(stderr, "workspace too small: need %zu have %zu\n", (size_t)WS_NEED, ws_size); return; }

  (void)hipMemsetAsync(d_ws, 0, 16384, stream);
#if COOP
  static int grid_blocks = 0;
  if (!grid_blocks) {
    int dev = 0, cus = 0, per_cu = 0;
    hipGetDevice(&dev);
    hipDeviceGetAttribute(&cus, hipDeviceAttributeMultiprocessorCount, dev);
    hipOccupancyMaxActiveBlocksPerMultiprocessor(&per_cu, mega, 256, 0);
    if (per_cu > 2) per_cu = 2;
    grid_blocks = cus * per_cu;
  }
  int lo = 0, hi = NPHASE;
  void* args[] = {&p, &lo, &hi};
  hipError_t e = hipLaunchCooperativeKernel((void*)mega, dim3(grid_blocks), dim3(256), args, 0, stream);
  if (e != hipSuccess) fprintf(stderr, "cooperative launch failed: %s (grid %d)\n", hipGetErrorString(e), grid_blocks);
#else
  for (int ph = 0; ph < NPHASE; ++ph) mega<<<512, 256, 0, stream>>>(p, ph, ph + 1);
#endif
}
```
